# Optimizing an MI355X kernel written in HIP

```python
import math
import jax, jax.numpy as jnp
from jax import lax
import numpy as np

D_MODEL = 2048
BATCH = 4
SEQ = 4096
DEPTH = 1

CHUNK = 64
Q_BLOCK = 128
HEAD_DIM = 128
SB_HEADS = 8
DN_HEADS = 8
SB_WIDTH = SB_HEADS * HEAD_DIM
DN_WIDTH = DN_HEADS * HEAD_DIM
MIX_WIDTH = SB_WIDTH + DN_WIDTH
SHORT_CONV = 4
FFN_CONV = 3
D_FF = 5632
IN_COLS = 3 * SB_WIDTH + 4 * DN_WIDTH + 2 * DN_HEADS
EPS = 1e-6

kernel_name = "sb_gdn_hybrid_convffn_block"


def rmsnorm(x, gain):
    xf = x.astype(jnp.float32)
    y = xf * lax.rsqrt(jnp.mean(xf * xf, axis=-1, keepdims=True) + EPS)
    return (y * gain.astype(jnp.float32)).astype(x.dtype)


def l2norm(x):
    xf = x.astype(jnp.float32)
    return xf * lax.rsqrt(jnp.sum(xf * xf, axis=-1, keepdims=True) + EPS)


def causal_dwconv(x, w):
    K = w.shape[0]
    T = x.shape[1]
    xp = jnp.pad(x, ((0, 0), (K - 1, 0), (0, 0)))
    out = xp[:, 0:T] * w[0]
    for j in range(1, K):
        out = out + xp[:, j:j + T] * w[j]
    return out


def _heads(t, n):
    B, T, _ = t.shape
    return t.reshape(B, T, n, HEAD_DIM).transpose(0, 2, 1, 3)


def stick_breaking_attention(q, k, v):
    B, H, T, Dh = q.shape
    scale = Dh ** -0.5
    outs = []
    for blk in range(T // Q_BLOCK):
        q0 = blk * Q_BLOCK
        kend = q0 + Q_BLOCK
        z = jnp.einsum('bhqd,bhkd->bhqk', q[:, :, q0:kend], k[:, :, :kend]).astype(jnp.float32) * scale
        t_idx = q0 + jnp.arange(Q_BLOCK)[:, None]
        s_idx = jnp.arange(kend)[None, :]
        valid = s_idx < t_idx
        log_beta = jax.nn.log_sigmoid(z)
        log_1m = jnp.where(valid, jax.nn.log_sigmoid(-z), 0.0)
        later = lax.cumsum(log_1m, axis=3, reverse=True) - log_1m
        att = jnp.where(valid, jnp.exp(log_beta + later), 0.0)
        outs.append(jnp.einsum('bhqk,bhkd->bhqd', att.astype(v.dtype), v[:, :, :kend]))
    return jnp.concatenate(outs, axis=2)


def gated_delta_rule(q, k, v, g, beta):
    out_dtype = v.dtype
    B, H, T, Dk = q.shape
    Dv = v.shape[-1]
    C = CHUNK
    N = T // C
    q = q.astype(jnp.float32) * (Dk ** -0.5)
    k = k.astype(jnp.float32)
    v = v.astype(jnp.float32)
    beta = beta.astype(jnp.float32)
    q = q.reshape(B, H, N, C, Dk)
    k = k.reshape(B, H, N, C, Dk)
    v = v.reshape(B, H, N, C, Dv)
    beta = beta.reshape(B, H, N, C)
    g = jnp.cumsum(g.astype(jnp.float32).reshape(B, H, N, C), axis=-1)

    causal = jnp.tril(jnp.ones((C, C), dtype=bool))
    strict = jnp.tril(jnp.ones((C, C), dtype=bool), k=-1)
    diff = g[..., :, None] - g[..., None, :]
    decay = jnp.where(causal, jnp.exp(jnp.where(causal, diff, 0.0)), 0.0)

    k_beta = k * beta[..., None]
    v_beta = v * beta[..., None]
    L = jnp.where(strict, jnp.einsum('bhncd,bhnmd->bhncm', k_beta, k) * decay, 0.0)
    eye = jnp.eye(C, dtype=jnp.float32)
    T_mat = lax.linalg.triangular_solve(eye + L, jnp.broadcast_to(eye, L.shape),
                                        left_side=True, lower=True, unit_diagonal=True)
    u = jnp.einsum('bhncm,bhnmd->bhncd', T_mat, v_beta)
    w = jnp.einsum('bhncm,bhnmd->bhncd', T_mat, k_beta * jnp.exp(g)[..., None])
    qk_intra = jnp.where(causal, jnp.einsum('bhncd,bhnmd->bhncm', q, k) * decay, 0.0)
    g_last = g[..., -1]
    k_to_end = k * jnp.exp(g_last[..., None] - g)[..., None]
    q_decay = q * jnp.exp(g)[..., None]

    def step(S, xs):
        u_i, w_i, qa_i, qd_i, kt_i, gl_i = xs
        v_new = u_i - jnp.einsum('bhcd,bhde->bhce', w_i, S)
        o = jnp.einsum('bhcd,bhde->bhce', qd_i, S) + jnp.einsum('bhcm,bhme->bhce', qa_i, v_new)
        S = S * jnp.exp(gl_i)[..., None, None] + jnp.einsum('bhcd,bhce->bhde', kt_i, v_new)
        return S, o

    to_scan = lambda t: jnp.moveaxis(t, 2, 0)
    xs = (to_scan(u), to_scan(w), to_scan(qk_intra), to_scan(q_decay), to_scan(k_to_end),
          jnp.moveaxis(g_last, 2, 0))
    S0 = jnp.zeros((B, H, Dk, Dv), dtype=jnp.float32)
    _, o = lax.scan(step, S0, xs)
    o = jnp.moveaxis(o, 0, 2).reshape(B, H, T, Dv)
    return o.astype(out_dtype)


def token_mixer(xn, w_in, sb_out_gain, dn_conv_w, dn_a_log, dn_dt_bias, dn_out_gain, w_out):
    B, T, _ = xn.shape
    proj = jnp.einsum('btd,dc->btc', xn, w_in)
    sizes = (SB_WIDTH, SB_WIDTH, SB_WIDTH, 3 * DN_WIDTH, DN_WIDTH, DN_HEADS, DN_HEADS)
    offs = np.cumsum(sizes)[:-1].tolist()
    sb_q, sb_k, sb_v, dn_qkv, dn_z, dn_b, dn_a = jnp.split(proj, offs, axis=-1)

    o_sb = stick_breaking_attention(_heads(sb_q, SB_HEADS), _heads(sb_k, SB_HEADS), _heads(sb_v, SB_HEADS))
    o_sb = rmsnorm(o_sb.transpose(0, 2, 1, 3), sb_out_gain).reshape(B, T, SB_WIDTH)

    dn_qkv = jax.nn.silu(causal_dwconv(dn_qkv, dn_conv_w))
    dq, dk, dv = jnp.split(dn_qkv, 3, axis=-1)
    q = l2norm(_heads(dq, DN_HEADS))
    k = l2norm(_heads(dk, DN_HEADS))
    v = _heads(dv, DN_HEADS)
    beta = jax.nn.sigmoid(dn_b.astype(jnp.float32)).transpose(0, 2, 1)
    g = -(jnp.exp(dn_a_log.astype(jnp.float32)) *
          jax.nn.softplus(dn_a.astype(jnp.float32) + dn_dt_bias.astype(jnp.float32))).transpose(0, 2, 1)
    o_dn = gated_delta_rule(q, k, v, g, beta).transpose(0, 2, 1, 3)
    o_dn = rmsnorm(o_dn, dn_out_gain) * jax.nn.silu(dn_z.reshape(B, T, DN_HEADS, HEAD_DIM))
    o_dn = o_dn.reshape(B, T, DN_WIDTH).astype(xn.dtype)

    mix = jnp.concatenate([o_sb.astype(xn.dtype), o_dn], axis=-1)
    return jnp.einsum('btc,cd->btd', mix, w_out)


def conv_ffn(xn, w_up, ffn_conv_w, ffn_conv_b, w_down):
    h = jnp.einsum('btd,df->btf', xn, w_up)
    h = causal_dwconv(h, ffn_conv_w) + ffn_conv_b
    gate, val = jnp.split(h, 2, axis=-1)
    return jnp.einsum('btf,fd->btd', jax.nn.gelu(gate, approximate=True) * val, w_down)


def setup_inputs(seed: int = 0) -> dict:
    key = jax.random.key(seed)
    ks = jax.random.split(key, 20)
    f32 = jnp.float32
    nrm = lambda k, shape, s: jax.random.normal(k, shape, f32) * s
    gain = lambda k, shape: 1.0 + 0.05 * jax.random.normal(k, shape, f32)
    dt = jnp.exp(jax.random.uniform(ks[5], (DEPTH, DN_HEADS), f32, math.log(1e-3), math.log(1e-1)))
    return {
        "x": jax.random.normal(ks[0], (BATCH, SEQ, D_MODEL), f32),
        "w_in": nrm(ks[1], (DEPTH, D_MODEL, IN_COLS), D_MODEL ** -0.5),
        "sb_out_gain": gain(ks[2], (DEPTH, HEAD_DIM)),
        "dn_conv_w": nrm(ks[3], (DEPTH, SHORT_CONV, 3 * DN_WIDTH), SHORT_CONV ** -0.5),
        "dn_a_log": jnp.log(jax.random.uniform(ks[4], (DEPTH, DN_HEADS), f32, 1.0, 16.0)),
        "dn_dt_bias": dt + jnp.log(-jnp.expm1(-dt)),
        "dn_out_gain": gain(ks[6], (DEPTH, HEAD_DIM)),
        "w_out": nrm(ks[7], (DEPTH, MIX_WIDTH, D_MODEL), MIX_WIDTH ** -0.5),
        "ln_mix_pre": gain(ks[8], (DEPTH, D_MODEL)),
        "ln_mix_post": gain(ks[9], (DEPTH, D_MODEL)),
        "w_up": nrm(ks[10], (DEPTH, D_MODEL, 2 * D_FF), D_MODEL ** -0.5),
        "ffn_conv_w": nrm(ks[11], (DEPTH, FFN_CONV, 2 * D_FF), FFN_CONV ** -0.5),
        "ffn_conv_b": nrm(ks[12], (DEPTH, 2 * D_FF), 0.01),
        "w_down": nrm(ks[13], (DEPTH, D_FF, D_MODEL), D_FF ** -0.5),
        "ln_ffn_pre": gain(ks[14], (DEPTH, D_MODEL)),
        "ln_ffn_post": gain(ks[15], (DEPTH, D_MODEL)),
    }


def reference(x, w_in, sb_out_gain, dn_conv_w, dn_a_log, dn_dt_bias, dn_out_gain, w_out,
              ln_mix_pre, ln_mix_post, w_up, ffn_conv_w, ffn_conv_b, w_down, ln_ffn_pre, ln_ffn_post):
    h = x
    for l in range(DEPTH):
        m = token_mixer(rmsnorm(h, ln_mix_pre[l]), w_in[l], sb_out_gain[l], dn_conv_w[l],
                        dn_a_log[l], dn_dt_bias[l], dn_out_gain[l], w_out[l])
        h = h + rmsnorm(m, ln_mix_post[l])
        f = conv_ffn(rmsnorm(h, ln_ffn_pre[l]), w_up[l], ffn_conv_w[l], ffn_conv_b[l], w_down[l])
        h = h + rmsnorm(f, ln_ffn_post[l])
    return h
```

```cpp
#include <hip/hip_runtime.h>
#include <hip/hip_cooperative_groups.h>
#include <cstdio>
namespace cg = cooperative_groups;

typedef unsigned short bf16_t;
typedef short bf16x8 __attribute__((ext_vector_type(8)));
typedef float f32x4 __attribute__((ext_vector_type(4)));
typedef float f32x16 __attribute__((ext_vector_type(16)));
typedef unsigned u32x4 __attribute__((ext_vector_type(4)));
typedef unsigned u32x2 __attribute__((ext_vector_type(2)));
#define DI __device__ __forceinline__

constexpr int D_MODEL = 2048, BATCH = 4, SEQ = 4096, NTOK = BATCH * SEQ;
constexpr int PROJ_N = 7168;
constexpr int IN_COLS = 7184;
constexpr int D_FF = 5632, UP_N = 2 * D_FF;
constexpr int NCHUNK = BATCH * 8 * 64;
constexpr float EPS = 1e-6f;
constexpr int NTHREADS = 512;
constexpr int CS_LD = 264;
constexpr int LDS_BYTES = 163840;
#ifndef DN_V1
#define DN_V1 0
#endif

constexpr size_t MiB = 1024ull * 1024ull;
constexpr size_t OFF_WUPT = 0, OFF_WDOWNT = 44 * MiB, OFF_A = 66 * MiB, OFF_WINT = 130 * MiB, OFF_WOUTT = 158 * MiB,
                 OFF_EXT = 166 * MiB, OFF_GL = 167 * MiB, OFF_QCTR = 167 * MiB + 65536, OFF_BAR = 167 * MiB + 65536 + 1024, OFF_HALO = 168 * MiB, OFF_PROJ = 174 * MiB, OFF_QA = 398 * MiB,
                 OFF_ODN = 414 * MiB, OFF_M = 414 * MiB  , OFF_ACT = 174 * MiB, OFF_F = 350 * MiB;

struct Params {
  const float* x; const float* w_in; const float* sb_gain; const float* dn_conv_w; const float* dn_a_log; const float* dn_dt_bias;
  const float* dn_gain; const float* w_out; const float* ln_mix_pre; const float* ln_mix_post; const float* w_up; const float* ffn_conv_w;
  const float* ffn_conv_b; const float* w_down; const float* ln_ffn_pre; const float* ln_ffn_post;
  float* out; char* ws;
  int phase_begin, phase_end;
};

typedef float f32x2_t __attribute__((ext_vector_type(2)));
typedef __bf16 bf16x2_t __attribute__((ext_vector_type(2)));
DI unsigned pk_bf16_mfma(float lo, float hi) { const f32x2_t v = {lo, hi}; return __builtin_bit_cast(unsigned, __builtin_convertvector(v, bf16x2_t)); }
DI unsigned pk_bf16(float lo, float hi) { unsigned r; asm("v_cvt_pk_bf16_f32 %0, %1, %2" : "=v"(r) : "v"(lo), "v"(hi)); return r; }
DI float bf2f(bf16_t v) { return __uint_as_float(((unsigned)v) << 16); }
DI float bflo(unsigned v) { return __uint_as_float(v << 16); }
DI float bfhi(unsigned v) { return __uint_as_float(v & 0xffff0000u); }
DI float wave_sum(float v) {
#pragma unroll
  for (int o = 32; o >= 1; o >>= 1) v += __shfl_xor(v, o);
  return v;
}
DI float sigmoidf_(float x) { return __builtin_amdgcn_rcpf(1.f + __expf(-x)); }
DI float siluf_(float x) { return x * __builtin_amdgcn_rcpf(1.f + __expf(-x)); }
DI float softplusf_(float x) { return fmaxf(x, 0.f) + __logf(1.f + __expf(-fabsf(x))); }
DI float gelu_tanh(float x) { float u = 0.7978845608028654f * (x + 0.044715f * x * x * x); return x * __builtin_amdgcn_rcpf(1.f + __expf(-2.f * u)); }
DI int launder_tid() { int t = threadIdx.x; asm volatile("" : "+v"(t)); return t; }
DI void wave_lds_sync() { asm volatile("s_waitcnt lgkmcnt(0)" ::: "memory"); __builtin_amdgcn_wave_barrier(); }

constexpr int BM = 256, BK = 64, HALF = 128, NXCD = 8, WGM = 8, HT = HALF * BK;
DI int lds_byte(int r, int c) { int st = (r >> 4) * 2 + (c >> 5), rr = r & 15, cc = c & 31, ob = rr * 64 + cc * 2; return st * 1024 + (ob ^ (((ob >> 9) & 1) << 5)); }
DI void stage_rc(int b, int& R, int& C) { int st = b / 1024, sb = b % 1024, swz = sb ^ (((sb >> 9) & 1) << 5); R = (st >> 1) * 16 + swz / 64; C = (st & 1) * 32 + (swz % 64) / 2; }

#define LAS __attribute__((address_space(3)))
constexpr int HTB = HT * 2;
DI void gemm_tile(const bf16_t* __restrict__ A, const bf16_t* __restrict__ Bt, int K, int brow, int bcol, LAS unsigned char* lds, f32x4 (&acc)[2][2][4][2]) {
  const int TIDX = launder_tid();
  const int tid = TIDX, wid = __builtin_amdgcn_readfirstlane(tid >> 6), lane = tid & 63, wr = wid >> 2, wc = wid & 3, fr = lane & 15, fq = lane >> 4;
  const int nt = K / BK;
  unsigned voff[2];
#pragma unroll
  for (int i = 0; i < 2; ++i) { int R, C; stage_rc(tid * 16 + i * 8192, R, C); voff[i] = (unsigned)(R * K + C) * 2u; }
  const size_t kstep = (size_t)(BK * 2), hstep = (size_t)HALF * K * 2;
  const unsigned ldsw = (unsigned)wid * 1024u;
  const int aoff = lds_byte(wr * 64 + fr, fq * 8), boff = lds_byte(wc * 32 + fr, fq * 8);
#define SA(b, h) (((b) * 2 + (h)) * HTB)
#define SB(b, h) ((4 + (b) * 2 + (h)) * HTB)
#define STAGE(bufoff, gbase) do { _Pragma("unroll") for (int _i = 0; _i < 2; ++_i) \
    __builtin_amdgcn_global_load_lds((const unsigned*)((const char*)(gbase) + voff[_i]), (LAS unsigned*)(lds + (bufoff) + ldsw + _i * 8192), 16, 0, 0); } while (0)
#define LDA(dst, b, h) do { _Pragma("unroll") for (int m = 0; m < 4; ++m) _Pragma("unroll") for (int k = 0; k < 2; ++k) dst[m][k] = *(const LAS bf16x8*)(lds + SA(b, h) + aoff + m * 2048 + k * 1024); } while (0)
#define LDB(dst, b, h) do { _Pragma("unroll") for (int n = 0; n < 2; ++n) _Pragma("unroll") for (int k = 0; k < 2; ++k) dst[n][k] = *(const LAS bf16x8*)(lds + SB(b, h) + boff + n * 2048 + k * 1024); } while (0)
#define MMA(ai, bj, At, Bq) do { __builtin_amdgcn_s_setprio(1); _Pragma("unroll") for (int m = 0; m < 4; ++m) _Pragma("unroll") for (int n = 0; n < 2; ++n) _Pragma("unroll") for (int k = 0; k < 2; ++k) \
      acc[ai][bj][m][n] = __builtin_amdgcn_mfma_f32_16x16x32_bf16(Bq[n][k], At[m][k], acc[ai][bj][m][n], 0, 0, 0); \
    __builtin_amdgcn_s_setprio(0); } while (0)
#define WAIT_V(n) asm volatile("s_waitcnt vmcnt(" #n ")" ::: "memory")
#define WAIT_L(n) asm volatile("s_waitcnt lgkmcnt(" #n ")" ::: "memory")
#define BAR __builtin_amdgcn_s_barrier()
#define SCHED __builtin_amdgcn_sched_barrier(0)
#pragma unroll
  for (int a = 0; a < 2; ++a)
#pragma unroll
    for (int b = 0; b < 2; ++b)
#pragma unroll
      for (int m = 0; m < 4; ++m)
#pragma unroll
        for (int n = 0; n < 2; ++n) acc[a][b][m][n] = (f32x4){0.f, 0.f, 0.f, 0.f};
  bf16x8 At[4][2], B0[2][2], B1[2][2];
  const char* cA = (const char*)A + (size_t)brow * K * 2; const char* cB = (const char*)Bt + (size_t)bcol * K * 2;
  STAGE(SB(0, 0), cB); STAGE(SA(0, 0), cA); STAGE(SB(0, 1), cB + hstep); STAGE(SA(0, 1), cA + hstep);
  if (wr == 1) BAR;
  WAIT_V(4); BAR;
  STAGE(SB(1, 0), cB + kstep); STAGE(SA(1, 0), cA + kstep); STAGE(SB(1, 1), cB + hstep + kstep);
  WAIT_V(6); BAR;
  for (int t = 0; t < nt - 2; t += 2) {
    const char* a1 = cA + (size_t)(t + 1) * kstep;
    const char* a2 = cA + (size_t)(t + 2) * kstep; const char* b2 = cB + (size_t)(t + 2) * kstep;
    const char* a3 = a2 + kstep; const char* b3 = b2 + kstep;
    LDB(B0, 0, 0); SCHED; LDA(At, 0, 0); STAGE(SA(1, 1), a1 + hstep);
    WAIT_L(8); BAR; WAIT_L(0); MMA(0, 0, At, B0); BAR; SCHED;
    LDB(B1, 0, 1); STAGE(SB(0, 0), b2);
    BAR; WAIT_L(0); MMA(0, 1, At, B1); BAR;
    LDA(At, 0, 1); STAGE(SA(0, 0), a2);
    BAR; WAIT_L(0); MMA(1, 0, At, B0); BAR; SCHED;
    STAGE(SB(0, 1), b2 + hstep);
    WAIT_V(6); BAR; MMA(1, 1, At, B1); BAR;
    LDB(B0, 1, 0); SCHED; LDA(At, 1, 0); STAGE(SA(0, 1), a2 + hstep);
    WAIT_L(8); BAR; WAIT_L(0); MMA(0, 0, At, B0); BAR; SCHED;
    LDB(B1, 1, 1); STAGE(SB(1, 0), b3);
    BAR; WAIT_L(0); MMA(0, 1, At, B1); BAR;
    LDA(At, 1, 1); STAGE(SA(1, 0), a3);
    BAR; WAIT_L(0); MMA(1, 0, At, B0); BAR; SCHED;
    STAGE(SB(1, 1), b3 + hstep);
    WAIT_V(6); BAR; MMA(1, 1, At, B1); BAR;
  }
  { LDB(B0, 0, 0); LDA(At, 0, 0); STAGE(SA(1, 1), cA + (size_t)(nt - 1) * kstep + hstep);
    BAR; WAIT_L(0); MMA(0, 0, At, B0); BAR;
    LDB(B1, 0, 1); BAR; WAIT_L(0); MMA(0, 1, At, B1); BAR;
    LDA(At, 0, 1); WAIT_V(4); BAR; WAIT_L(0); MMA(1, 0, At, B0); MMA(1, 1, At, B1); BAR; }
  { LDB(B0, 1, 0); LDA(At, 1, 0); WAIT_V(2); BAR; WAIT_L(0); MMA(0, 0, At, B0); BAR;
    LDB(B1, 1, 1); WAIT_V(0); BAR; WAIT_L(0); MMA(0, 1, At, B1); BAR;
    LDA(At, 1, 1); BAR; WAIT_L(0); MMA(1, 0, At, B0); MMA(1, 1, At, B1); BAR; }
  if (wr == 0) BAR;
#undef SA
#undef SB
#undef STAGE
#undef LDA
#undef LDB
#undef MMA
}

DI void tile_of(int L, int nM, int nN, int& pm, int& pn) {
  const int nwg = nM * nN;
  int wgid = L; { const int q = nwg / NXCD, r = nwg % NXCD, xcd = wgid % NXCD, off = wgid / NXCD; wgid = (xcd < r ? xcd * (q + 1) : r * (q + 1) + (xcd - r) * q) + off; }
  const int nig = WGM * nN, gid = wgid / nig, fm = gid * WGM, gsz = (nM - fm) < WGM ? (nM - fm) : WGM;
  pm = fm + ((wgid % nig) % gsz); pn = (wgid % nig) / gsz;
}

DI void stage_c_bf16(const f32x4 (&acc)[2][2][4][2], bf16_t* Cs) {
  const int TIDX = launder_tid();
  const int wid = TIDX >> 6, lane = TIDX & 63, wr = wid >> 2, wc = wid & 3, fr = lane & 15, fq = lane >> 4;
#pragma unroll
  for (int ai = 0; ai < 2; ++ai)
#pragma unroll
    for (int bj = 0; bj < 2; ++bj)
#pragma unroll
      for (int m = 0; m < 4; ++m)
#pragma unroll
        for (int n = 0; n < 2; ++n) {
          const int row = ai * 128 + wr * 64 + m * 16 + fr, col = bj * 128 + wc * 32 + n * 16 + 4 * fq;
          u32x2 v; v.x = pk_bf16_mfma(acc[ai][bj][m][n][0], acc[ai][bj][m][n][1]); v.y = pk_bf16_mfma(acc[ai][bj][m][n][2], acc[ai][bj][m][n][3]);
          *(u32x2*)(Cs + row * CS_LD + col) = v;
        }
}

template <int EPI>
DI void gemm_phase(const Params& p, const bf16_t* A, const bf16_t* Bt, int M, int N, int K, void* outp, bf16_t* halo, char* smem) {
  const int TIDX = launder_tid();
  const int nM = M / BM, nN = N / BM, nwg = nM * nN;
  bf16_t* shm = (bf16_t*)smem;
  for (int L = blockIdx.x; L < nwg; L += gridDim.x) {
    int pm, pn; tile_of(L, nM, nN, pm, pn);
    const int brow = pm * BM, bcol = pn * BM;
    f32x4 acc[2][2][4][2];
    gemm_tile(A, Bt, K, brow, bcol, (LAS unsigned char*)smem, acc);
    if (EPI == 1) {
      bf16_t* O = (bf16_t*)outp;
      const int wid = TIDX >> 6, lane = TIDX & 63, wr = wid >> 2, wc = wid & 3, fr = lane & 15, fq = lane >> 4;
#pragma unroll
      for (int ai = 0; ai < 2; ++ai)
#pragma unroll
        for (int m = 0; m < 4; ++m) {
          bf16_t* rowp = O + (size_t)(brow + ai * 128 + wr * 64 + m * 16 + fr) * N + bcol + wc * 32 + 4 * fq;
#pragma unroll
          for (int bj = 0; bj < 2; ++bj)
#pragma unroll
            for (int n = 0; n < 2; ++n) { u32x2 v; v.x = pk_bf16_mfma(acc[ai][bj][m][n][0], acc[ai][bj][m][n][1]); v.y = pk_bf16_mfma(acc[ai][bj][m][n][2], acc[ai][bj][m][n][3]); *(u32x2*)(rowp + bj * 128 + n * 16) = v; }
        }
    } else {
      bf16_t* Cs = shm;
      stage_c_bf16(acc, Cs);
      __syncthreads();
      if (EPI == 0) {
        bf16_t* O = (bf16_t*)outp;
#pragma unroll 4
        for (int i = 0; i < 16; ++i) {
          const int id = TIDX + NTHREADS * i, row = id >> 5, ch = id & 31;
          const u32x4 v = *(const u32x4*)(Cs + row * CS_LD + ch * 8);
          *(u32x4*)(O + (size_t)(brow + row) * N + bcol + ch * 8) = v;
        }
      } else {
        bf16_t* ACT = (bf16_t*)outp;
        const int cgp = TIDX & 15, r0 = TIDX >> 4;
        const int gcol = pn * 128 + cgp * 8;
        float wg[3][8], wv[3][8], bg[8], bv[8];
#pragma unroll
        for (int k = 0; k < 3; ++k)
#pragma unroll
          for (int c = 0; c < 8; ++c) { wg[k][c] = p.ffn_conv_w[k * UP_N + gcol + c]; wv[k][c] = p.ffn_conv_w[k * UP_N + D_FF + gcol + c]; }
#pragma unroll
        for (int c = 0; c < 8; ++c) { bg[c] = p.ffn_conv_b[gcol + c]; bv[c] = p.ffn_conv_b[D_FF + gcol + c]; }
        const bool seq_start = (brow % SEQ) == 0;
        for (int i = 0; i < 8; ++i) {
          const int row = r0 + 32 * i;
          if (row < 2 && !seq_start) continue;
          float g[8], v[8];
#pragma unroll
          for (int c = 0; c < 8; ++c) { g[c] = bg[c]; v[c] = bv[c]; }
#pragma unroll
          for (int k = 0; k < 3; ++k) {
            const int rr = row - 2 + k;
            if (rr < 0) continue;
            const u32x4 gq = *(const u32x4*)(Cs + rr * CS_LD + cgp * 8);
            const u32x4 vq = *(const u32x4*)(Cs + rr * CS_LD + 128 + cgp * 8);
#pragma unroll
            for (int c2 = 0; c2 < 4; ++c2) {
              g[2 * c2] += wg[k][2 * c2] * bflo(gq[c2]); g[2 * c2 + 1] += wg[k][2 * c2 + 1] * bfhi(gq[c2]);
              v[2 * c2] += wv[k][2 * c2] * bflo(vq[c2]); v[2 * c2 + 1] += wv[k][2 * c2 + 1] * bfhi(vq[c2]);
            }
          }
          u32x4 o;
#pragma unroll
          for (int c2 = 0; c2 < 4; ++c2) o[c2] = pk_bf16(gelu_tanh(g[2 * c2]) * v[2 * c2], gelu_tanh(g[2 * c2 + 1]) * v[2 * c2 + 1]);
          *(u32x4*)(ACT + (size_t)(brow + row) * D_FF + gcol) = o;
        }
        if (TIDX < 128) {
          const int slot = TIDX >> 5, ch = TIDX & 31;
          const int row = slot < 2 ? slot : 252 + slot;
          *(u32x4*)(halo + ((size_t)(pm * 4 + slot) * UP_N) + pn * 256 + ch * 8) = *(const u32x4*)(Cs + row * CS_LD + ch * 8);
        }
      }
    }
    __syncthreads();
  }
}

DI void ffn_fix_phase(const Params& p, const bf16_t* halo, bf16_t* ACT) {
  const int TIDX = launder_tid();
  const int total = 64 * 2 * 44 * 16;
  for (int id = blockIdx.x * NTHREADS + TIDX; id < total; id += gridDim.x * NTHREADS) {
    const int cgp = id & 15; int t = id >> 4; const int pn = t % 44; t /= 44; const int rr = t & 1; const int pm = t >> 1;
    if ((pm & 15) == 0) continue;
    const int gcol = pn * 128 + cgp * 8;
    float g[8], v[8];
#pragma unroll
    for (int c = 0; c < 8; ++c) { g[c] = p.ffn_conv_b[gcol + c]; v[c] = p.ffn_conv_b[D_FF + gcol + c]; }
#pragma unroll
    for (int k = 0; k < 3; ++k) {
      const int r = rr - 2 + k;
      const bf16_t* src = r < 0 ? halo + (size_t)((pm - 1) * 4 + 4 + r) * UP_N : halo + (size_t)(pm * 4 + r) * UP_N;
      const u32x4 gq = *(const u32x4*)(src + pn * 256 + cgp * 8);
      const u32x4 vq = *(const u32x4*)(src + pn * 256 + 128 + cgp * 8);
#pragma unroll
      for (int c2 = 0; c2 < 4; ++c2) {
        g[2 * c2] += p.ffn_conv_w[k * UP_N + gcol + 2 * c2] * bflo(gq[c2]); g[2 * c2 + 1] += p.ffn_conv_w[k * UP_N + gcol + 2 * c2 + 1] * bfhi(gq[c2]);
        v[2 * c2] += p.ffn_conv_w[k * UP_N + D_FF + gcol + 2 * c2] * bflo(vq[c2]); v[2 * c2 + 1] += p.ffn_conv_w[k * UP_N + D_FF + gcol + 2 * c2 + 1] * bfhi(vq[c2]);
      }
    }
    u32x4 o;
#pragma unroll
    for (int c2 = 0; c2 < 4; ++c2) o[c2] = pk_bf16(gelu_tanh(g[2 * c2]) * v[2 * c2], gelu_tanh(g[2 * c2 + 1]) * v[2 * c2 + 1]);
    *(u32x4*)(ACT + (size_t)(pm * 256 + rr) * D_FF + gcol) = o;
  }
}

DI void transpose_group(const float* __restrict__ src, int ld_src, int K, int mode, bf16_t* __restrict__ dst, char* smem, int group) {
  const int TIDX = launder_tid();
  bf16_t* T = (bf16_t*)smem;
  const int gk = K / 256, tk4 = group % gk, tn = group / gk;
  int scol = tn * 64;
  if (mode == 1) { const int nt = tn >> 2, sub = tn & 3; scol = (sub < 2 ? 0 : D_FF) + nt * 128 + (sub & 1) * 64; }
  const int kq = TIDX >> 4, n4 = (TIDX & 15) * 4;
  f32x4 v[8];
#pragma unroll
  for (int i = 0; i < 8; ++i) v[i] = *(const f32x4*)(src + (size_t)(tk4 * 256 + kq + 32 * i) * ld_src + scol + n4);
#pragma unroll
  for (int i = 0; i < 8; ++i) {
    const int k = kq + 32 * (i & 1); bf16_t* Tq = T + (i >> 1) * (64 * 72);
    const unsigned a = pk_bf16(v[i][0], v[i][1]), b = pk_bf16(v[i][2], v[i][3]);
    Tq[(n4 + 0) * 72 + k] = (bf16_t)(a & 0xffff); Tq[(n4 + 1) * 72 + k] = (bf16_t)(a >> 16);
    Tq[(n4 + 2) * 72 + k] = (bf16_t)(b & 0xffff); Tq[(n4 + 3) * 72 + k] = (bf16_t)(b >> 16);
  }
  __syncthreads();
  { const int n = TIDX >> 3, k8 = (TIDX & 7) * 8;
#pragma unroll
    for (int q = 0; q < 4; ++q) *(u32x4*)(dst + (size_t)(tn * 64 + n) * K + tk4 * 256 + q * 64 + k8) = *(const u32x4*)(T + q * (64 * 72) + n * 72 + k8); }
  __syncthreads();
}
constexpr int CONV_UNITS = (256 + 1408 + 704) / 4;
DI void convert_unit(const Params& p, int unit, char* smem) {
  char* ws = p.ws;
#pragma unroll 1
  for (int q = 0; q < 4; ++q) {
    int g = unit * 4 + q;
    if (g < 256) transpose_group(p.w_out, 2048, 2048, 0, (bf16_t*)(ws + OFF_WOUTT), smem, g);
    else if (g < 256 + 1408) transpose_group(p.w_up, UP_N, 2048, 1, (bf16_t*)(ws + OFF_WUPT), smem, g - 256);
    else transpose_group(p.w_down, 2048, 5632, 0, (bf16_t*)(ws + OFF_WDOWNT), smem, g - 256 - 1408);
  }
}

DI void prep_phase(const Params& p, char* smem) {
  const int TIDX = launder_tid();
  char* ws = p.ws;
  if (blockIdx.x == 0 && TIDX == 0) *(unsigned*)(ws + OFF_QCTR) = 0u;
  for (int g = blockIdx.x; g < 8 * 112; g += gridDim.x) transpose_group(p.w_in, IN_COLS, 2048, 0, (bf16_t*)(ws + OFF_WINT), smem, g);
  __syncthreads();
  float* Wl = (float*)smem;
  for (int i = TIDX; i < 2048 * 16; i += NTHREADS) { const int d = i >> 4, j = i & 15; Wl[j * 2048 + d] = p.w_in[(size_t)d * IN_COLS + PROJ_N + j]; }
  __syncthreads();
  const int wave = TIDX >> 6, lane = TIDX & 63;
  bf16_t* xn = (bf16_t*)(ws + OFF_A);
  float* ext = (float*)(ws + OFF_EXT);
  for (int row0 = 2 * (blockIdx.x * 8 + wave); row0 < NTOK; row0 += 2 * gridDim.x * 8) {
    f32x4 v[2][8]; float ss[2] = {0.f, 0.f};
#pragma unroll
    for (int q = 0; q < 2; ++q)
#pragma unroll
      for (int i = 0; i < 8; ++i) { v[q][i] = *(const f32x4*)(p.x + (size_t)(row0 + q) * D_MODEL + 4 * (lane + 64 * i)); ss[q] += v[q][i][0] * v[q][i][0] + v[q][i][1] * v[q][i][1] + v[q][i][2] * v[q][i][2] + v[q][i][3] * v[q][i][3]; }
#pragma unroll
    for (int q = 0; q < 2; ++q) {
      const float rs = rsqrtf(wave_sum(ss[q]) * (1.f / D_MODEL) + EPS);
#pragma unroll
      for (int i = 0; i < 8; ++i) {
        const f32x4 g = *(const f32x4*)(p.ln_mix_pre + 4 * (lane + 64 * i));
        v[q][i] = v[q][i] * rs * g;
        u32x2 o; o.x = pk_bf16(v[q][i][0], v[q][i][1]); o.y = pk_bf16(v[q][i][2], v[q][i][3]);
        *(u32x2*)(xn + (size_t)(row0 + q) * D_MODEL + 4 * (lane + 64 * i)) = o;
      }
    }
    float myv0 = 0.f, myv1 = 0.f;
#pragma unroll 1
    for (int j = 0; j < 16; ++j) {
      float a0 = 0.f, a1 = 0.f;
#pragma unroll
      for (int i = 0; i < 8; ++i) { const f32x4 w = *(const f32x4*)(Wl + j * 2048 + 4 * (lane + 64 * i));
        a0 += v[0][i][0] * w[0] + v[0][i][1] * w[1] + v[0][i][2] * w[2] + v[0][i][3] * w[3];
        a1 += v[1][i][0] * w[0] + v[1][i][1] * w[1] + v[1][i][2] * w[2] + v[1][i][3] * w[3]; }
      a0 = wave_sum(a0); a1 = wave_sum(a1);
      if (lane == j) { myv0 = a0; myv1 = a1; }
    }
    if (lane < 16) { ext[(size_t)row0 * 16 + lane] = myv0; ext[(size_t)(row0 + 1) * 16 + lane] = myv1; }
  }
}

DI int permcol(int c) { const int g = (c >> 2) & 7; const int ng = g < 4 ? 2 * g : 2 * (g - 4) + 1; return (c & ~31) | (ng << 2) | (c & 3); }
constexpr int QS_LD = 132, LM_LD = 68;
DI void dn_chunk(const Params& p, int chunk, char* smem) {
  const int TIDX = launder_tid();
  char* ws = p.ws;
  const bf16_t* proj = (const bf16_t*)(ws + OFF_PROJ);
  const float* ext = (const float*)(ws + OFF_EXT);
  bf16_t* Ug = (bf16_t*)p.out;
  bf16_t* Wg = Ug + (size_t)NCHUNK * 8192; bf16_t* QDg = Wg + (size_t)NCHUNK * 8192; bf16_t* KTg = QDg + (size_t)NCHUNK * 8192;
  bf16_t* QAg = (bf16_t*)(ws + OFF_QA);
  float* GL = (float*)(ws + OFF_GL);
  float* qs = (float*)smem; float* ks = qs + 64 * QS_LD; float* vs = ks + 64 * QS_LD; float* Lm = vs + 64 * QS_LD;
  float* gcs = Lm + 64 * LM_LD; float* betas = gcs + 64;
  const int bh = chunk >> 6, n = chunk & 63, b = bh >> 3, h = bh & 7;
  const int tid = TIDX, wave = tid >> 6, lane = tid & 63;
  const size_t tok0 = (size_t)b * SEQ + n * 64;
#ifndef PROBE_DN123
#define PROBE_DN123 1
#endif
  for (int rp_ = 0; rp_ < PROBE_DN123; ++rp_) {
  if (tid < 384) {
    const int cq = tid % 96, tg = tid / 96;
    const int part = cq >> 5, within = (cq & 31) * 4;
    const int wcol = part * 1024 + h * 128 + within;
    float w[4][4];
#pragma unroll
    for (int k = 0; k < 4; ++k)
#pragma unroll
      for (int c = 0; c < 4; ++c) w[k][c] = p.dn_conv_w[k * 3072 + wcol + c];
    float win[3][4];
    const int pos0 = n * 64 + tg * 16;
#pragma unroll
    for (int i = 0; i < 3; ++i) {
      const int pos = pos0 - 3 + i;
      if (pos >= 0) { const u32x2 r = *(const u32x2*)(proj + ((size_t)b * SEQ + pos) * PROJ_N + 3072 + wcol); win[i][0] = bflo(r.x); win[i][1] = bfhi(r.x); win[i][2] = bflo(r.y); win[i][3] = bfhi(r.y); }
      else { win[i][0] = win[i][1] = win[i][2] = win[i][3] = 0.f; }
    }
    float* dstbase = (part == 0 ? qs : part == 1 ? ks : vs) + within;
#pragma unroll
    for (int i = 0; i < 16; ++i) {
      const u32x2 r = *(const u32x2*)(proj + ((size_t)b * SEQ + pos0 + i) * PROJ_N + 3072 + wcol);
      float cur[4] = {bflo(r.x), bfhi(r.x), bflo(r.y), bfhi(r.y)};
      f32x4 o;
#pragma unroll
      for (int c = 0; c < 4; ++c) { const float a = w[0][c] * win[0][c] + w[1][c] * win[1][c] + w[2][c] * win[2][c] + w[3][c] * cur[c]; o[c] = siluf_(a); win[0][c] = win[1][c]; win[1][c] = win[2][c]; win[2][c] = cur[c]; }
      *(f32x4*)(dstbase + (tg * 16 + i) * QS_LD) = o;
    }
  } else if (wave == 7) {
    const float bl = ext[(tok0 + lane) * 16 + h], al = ext[(tok0 + lane) * 16 + 8 + h];
    float g = -__expf(p.dn_a_log[h]) * softplusf_(al + p.dn_dt_bias[h]);
#pragma unroll
    for (int o = 1; o < 64; o <<= 1) { const float t = __shfl_up(g, o); if (lane >= o) g += t; }
    gcs[lane] = g; betas[lane] = sigmoidf_(bl);
    if (lane == 63) GL[chunk] = g;
  }
  __syncthreads();
  {
    const int row = tid >> 2, part = tid & 3;
    float* base = (row < 64 ? qs + row * QS_LD : ks + (row - 64) * QS_LD) + part * 32;
    f32x4 v[8]; float ss = 0.f;
#pragma unroll
    for (int i = 0; i < 8; ++i) { v[i] = *(const f32x4*)(base + 4 * i); ss += v[i][0] * v[i][0] + v[i][1] * v[i][1] + v[i][2] * v[i][2] + v[i][3] * v[i][3]; }
    ss += __shfl_xor(ss, 1); ss += __shfl_xor(ss, 2);
    float rs = rsqrtf(ss + EPS); if (row < 64) rs *= 0.08838834764831845f;
#pragma unroll
    for (int i = 0; i < 8; ++i) *(f32x4*)(base + 4 * i) = v[i] * rs;
  }
  __syncthreads();
  {
    const int sel = wave >> 2, mb = wave & 3, r = lane & 15, quad = lane >> 4;
    const float* X = sel ? qs : ks;
    bf16x8 af[4];
#pragma unroll
    for (int kk = 0; kk < 4; ++kk) {
      const f32x4 a0 = *(const f32x4*)(X + (16 * mb + r) * QS_LD + 32 * kk + 8 * quad), a1 = *(const f32x4*)(X + (16 * mb + r) * QS_LD + 32 * kk + 8 * quad + 4);
      u32x4 t; t[0] = pk_bf16(a0[0], a0[1]); t[1] = pk_bf16(a0[2], a0[3]); t[2] = pk_bf16(a1[0], a1[1]); t[3] = pk_bf16(a1[2], a1[3]);
      af[kk] = __builtin_bit_cast(bf16x8, t);
    }
    for (int nb = 0; nb < 4; ++nb) {
      f32x4 d = {0.f, 0.f, 0.f, 0.f};
      if (nb <= mb) {
#pragma unroll
        for (int kk = 0; kk < 4; ++kk) {
          const f32x4 b0 = *(const f32x4*)(ks + (16 * nb + r) * QS_LD + 32 * kk + 8 * quad), b1 = *(const f32x4*)(ks + (16 * nb + r) * QS_LD + 32 * kk + 8 * quad + 4);
          u32x4 t; t[0] = pk_bf16(b0[0], b0[1]); t[1] = pk_bf16(b0[2], b0[3]); t[2] = pk_bf16(b1[0], b1[1]); t[3] = pk_bf16(b1[2], b1[3]);
          d = __builtin_amdgcn_mfma_f32_16x16x32_bf16(af[kk], __builtin_bit_cast(bf16x8, t), d, 0, 0, 0);
        }
      }
      const int j = 16 * nb + r; const float gj = gcs[j];
#pragma unroll
      for (int reg = 0; reg < 4; ++reg) {
        const int i = 16 * mb + 4 * quad + reg;
        float val = 0.f;
        if (sel == 0) { if (j < i) val = d[reg] * __expf(gcs[i] - gj) * betas[i]; Lm[j * LM_LD + i] = val; }
        else { if (j <= i) val = d[reg] * __expf(gcs[i] - gj); QAg[(size_t)chunk * 4096 + i * 64 + permcol(j)] = (bf16_t)(pk_bf16(val, 0.f) & 0xffff); }
      }
    }
    { const int row = tid >> 3, c0 = (tid & 7) * 16; const float e = __expf(gcs[row]);
#pragma unroll
      for (int i = 0; i < 4; ++i) { const f32x4 v = *(const f32x4*)(qs + row * QS_LD + c0 + 4 * i) * e; u32x2 o; o.x = pk_bf16(v[0], v[1]); o.y = pk_bf16(v[2], v[3]);
        *(u32x2*)(QDg + (size_t)chunk * 8192 + row * 128 + permcol(c0 + 4 * i)) = o; } }
    { const int d = tid >> 2, t0 = (tid & 3) * 16; const float gl = gcs[63];
#pragma unroll
      for (int i = 0; i < 4; ++i) { float a[4];
#pragma unroll
        for (int e = 0; e < 4; ++e) a[e] = ks[(t0 + 4 * i + e) * QS_LD + d] * __expf(gl - gcs[t0 + 4 * i + e]);
        u32x2 o; o.x = pk_bf16(a[0], a[1]); o.y = pk_bf16(a[2], a[3]);
        *(u32x2*)(KTg + (size_t)chunk * 8192 + d * 64 + permcol(t0 + 4 * i)) = o; } }
  }
  __syncthreads();
  }
  if (tid < 256) {
    const int c = tid & 127; const bool isw = tid >= 128;
    float* src = (isw ? ks : vs) + c;
    bf16_t* dst = isw ? Wg + (size_t)chunk * 8192 + permcol(c) : Ug + (size_t)chunk * 8192 + c * 64;
#pragma unroll 1
    for (int ib = 0; ib < 4; ++ib) {
      float rr[16];
#pragma unroll
      for (int ii = 0; ii < 16; ++ii) { const int i = 16 * ib + ii; float v = src[i * QS_LD] * betas[i]; if (isw) v *= __expf(gcs[i]); rr[ii] = v; }
#pragma unroll 2
      for (int j = 0; j < 16 * ib; ++j) {
        const float xj = src[j * QS_LD];
        const f32x4* lp = (const f32x4*)(Lm + j * LM_LD + 16 * ib);
#pragma unroll
        for (int q = 0; q < 4; ++q) { const f32x4 l = lp[q];
#pragma unroll
          for (int e = 0; e < 4; ++e) rr[4 * q + e] -= l[e] * xj; }
      }
#pragma unroll
      for (int jj = 0; jj < 16; ++jj) {
        const float xj = rr[jj];
        src[(16 * ib + jj) * QS_LD] = xj;
        if (isw) dst[(16 * ib + jj) * 128] = (bf16_t)(pk_bf16(xj, 0.f) & 0xffff);
        else if ((jj & 3) == 3) { u32x2 o; o.x = pk_bf16(rr[jj - 3], rr[jj - 2]); o.y = pk_bf16(rr[jj - 1], xj); *(u32x2*)(dst + 16 * ib + jj - 3) = o; }
        const f32x4* lp = (const f32x4*)(Lm + (16 * ib + jj) * LM_LD + 16 * ib);
#pragma unroll
        for (int q = (jj + 1) / 4; q < 4; ++q) { const f32x4 l = lp[q];
#pragma unroll
          for (int e = 0; e < 4; ++e) if (4 * q + e > jj) rr[4 * q + e] -= l[e] * xj; }
      }
    }
  }
  __syncthreads();
}

typedef short s16x4 __attribute__((ext_vector_type(4)));
constexpr int WL_BYTES = 20480, TL_LD = 68;
DI int img_off(int row, int c32) { return row * 256 + ((c32 ^ (row & 7)) << 5); }
DI s16x4 tr_read1(unsigned a0);
DI bf16x8 tr_read2(unsigned a0, unsigned a1) {
  const s16x4 lo = tr_read1(a0), hi = tr_read1(a1);
  return __builtin_shufflevector(lo, hi, 0, 1, 2, 3, 4, 5, 6, 7);
}
DI void tr_read4(unsigned a0, unsigned a1, unsigned a2, unsigned a3, s16x4& r0, s16x4& r1, s16x4& r2, s16x4& r3) {
  asm volatile("ds_read_b64_tr_b16 %0, %4\n\tds_read_b64_tr_b16 %1, %5\n\tds_read_b64_tr_b16 %2, %6\n\tds_read_b64_tr_b16 %3, %7\n\ts_waitcnt lgkmcnt(0)"
               : "=&v"(r0), "=&v"(r1), "=&v"(r2), "=&v"(r3) : "v"(a0), "v"(a1), "v"(a2), "v"(a3) : "memory");
}
DI s16x4 tr_read1(unsigned a0) { s16x4 lo; asm volatile("ds_read_b64_tr_b16 %0, %1\n\ts_waitcnt lgkmcnt(0)" : "=&v"(lo) : "v"(a0) : "memory"); return lo; }
#ifndef DBG_NOSOLVE
#define DBG_NOSOLVE 0
#endif
#ifndef DNW_OUT
#define DNW_OUT 63
#endif
DI void dn_chunk_wave(const Params& p, int chunk_, char* smem_) {
  const int TIDX = launder_tid();
  const int chunk = __builtin_amdgcn_readfirstlane(chunk_);
  char* wl = smem_ + __builtin_amdgcn_readfirstlane(TIDX >> 6) * WL_BYTES;
  char* ws = p.ws;
  const bf16_t* proj = (const bf16_t*)(ws + OFF_PROJ);
  const float* ext = (const float*)(ws + OFF_EXT);
  bf16_t* Ug = (bf16_t*)p.out;
  bf16_t* Wg = Ug + (size_t)NCHUNK * 8192; bf16_t* QDg = Wg + (size_t)NCHUNK * 8192; bf16_t* KTg = QDg + (size_t)NCHUNK * 8192;
  bf16_t* QAg = (bf16_t*)(ws + OFF_QA);
  float* GL = (float*)(ws + OFF_GL);
  float* T = (float*)wl;
  const unsigned wl_addr = (unsigned)(size_t)wl;
  int lane = TIDX & 63;
#define r (lane & 15)
#define quad (lane >> 4)
#define RELAUNDER() asm volatile("" : "+v"(lane))
  const int bh = chunk >> 6, n = chunk & 63, b = bh >> 3, h = bh & 7;
  const size_t tok0 = (size_t)b * SEQ + n * 64;
  float gcl, betal;
  {
    const float bl = ext[(tok0 + lane) * 16 + h], al = ext[(tok0 + lane) * 16 + 8 + h];
    float g = -__expf(p.dn_a_log[h]) * softplusf_(al + p.dn_dt_bias[h]);
#pragma unroll
    for (int o = 1; o < 64; o <<= 1) { const float t = __shfl_up(g, o); if (lane >= o) g += t; }
    gcl = g; betal = sigmoidf_(bl);
    if ((DNW_OUT & 32) && lane == 63) GL[chunk] = g;
  }
  auto load_w = [&](int part, int kk, f32x4 (&wt)[4][2]) {
    const int col = part * 1024 + h * 128 + 32 * kk + 8 * quad;
#pragma unroll
    for (int tap = 0; tap < 4; ++tap) { const unsigned o = (unsigned)(tap * 3072 + col) * 4u; wt[tap][0] = *(const f32x4*)((const char*)p.dn_conv_w + o); wt[tap][1] = *(const f32x4*)((const char*)p.dn_conv_w + o + 16u); }
  };
  auto conv_frag = [&](int part, int mb, int kk, const f32x4 (&wt)[4][2], float (&out)[8]) {
    const int col = part * 1024 + h * 128 + 32 * kk + 8 * quad;
    float a[8];
#pragma unroll
    for (int c = 0; c < 8; ++c) a[c] = 0.f;
#pragma unroll
    for (int tap = 0; tap < 4; ++tap) {
      const int pos = n * 64 + 16 * mb + r - 3 + tap;
      u32x4 raw = {0u, 0u, 0u, 0u};
      if (pos >= 0) raw = *(const u32x4*)((const char*)proj + ((unsigned)(b * SEQ + pos) * (unsigned)PROJ_N + 3072u + (unsigned)col) * 2u);
      a[0] += wt[tap][0][0] * bflo(raw[0]); a[1] += wt[tap][0][1] * bfhi(raw[0]); a[2] += wt[tap][0][2] * bflo(raw[1]); a[3] += wt[tap][0][3] * bfhi(raw[1]);
      a[4] += wt[tap][1][0] * bflo(raw[2]); a[5] += wt[tap][1][1] * bfhi(raw[2]); a[6] += wt[tap][1][2] * bflo(raw[3]); a[7] += wt[tap][1][3] * bfhi(raw[3]);
    }
#pragma unroll
    for (int c = 0; c < 8; ++c) out[c] = siluf_(a[c]);
  };
  auto pack8 = [&](const float (&v)[8], float sc) -> bf16x8 {
    u32x4 t; t[0] = pk_bf16(v[0] * sc, v[1] * sc); t[1] = pk_bf16(v[2] * sc, v[3] * sc); t[2] = pk_bf16(v[4] * sc, v[5] * sc); t[3] = pk_bf16(v[6] * sc, v[7] * sc);
    return __builtin_bit_cast(bf16x8, t);
  };
  auto scale8 = [&](bf16x8 f, float sc) -> u32x4 {
    const u32x4 t = __builtin_bit_cast(u32x4, f); u32x4 o;
#pragma unroll
    for (int i = 0; i < 4; ++i) o[i] = pk_bf16(bflo(t[i]) * sc, bfhi(t[i]) * sc);
    return o;
  };
  bf16x8 kfrag[4][4];
  float rskl;
  {
    float ss[4] = {0.f, 0.f, 0.f, 0.f};
#pragma unroll
    for (int kk = 0; kk < 4; ++kk) {
      f32x4 wt[4][2]; load_w(1, kk, wt);
#pragma unroll
      for (int mb = 0; mb < 4; ++mb) { float f[8]; conv_frag(1, mb, kk, wt, f); kfrag[mb][kk] = pack8(f, 1.f);
#pragma unroll
        for (int c = 0; c < 8; ++c) ss[mb] += f[c] * f[c];
        if (mb == 3) { asm volatile("" ::: "memory"); __builtin_amdgcn_sched_barrier(0); } }
    }
#pragma unroll
    for (int mb = 0; mb < 4; ++mb) { float t = ss[mb]; t += __shfl_xor(t, 16); t += __shfl_xor(t, 32); ss[mb] = rsqrtf(t + EPS); }
    rskl = quad == 0 ? ss[0] : quad == 1 ? ss[1] : quad == 2 ? ss[2] : ss[3];
  }
#ifndef DNW_STOP
#define DNW_STOP 99
#endif
  if (DNW_STOP == 1) { if (kfrag[0][0][0] == 12345 && kfrag[3][3][1] == 7 && kfrag[1][2][3] == 5 && kfrag[2][1][0] == 9) GL[0] = 1.f; return; }
  RELAUNDER();
  const float glast = __shfl(gcl, 63);
  float gcr[4], betar[4], rskr[4];
#pragma unroll
  for (int mb = 0; mb < 4; ++mb) { gcr[mb] = __shfl(gcl, 16 * mb + r); betar[mb] = __shfl(betal, 16 * mb + r); rskr[mb] = __shfl(rskl, 16 * mb + r); }
#pragma unroll
  for (int mb = 0; mb < 4; ++mb) {
    float gci[4], bi[4];
#pragma unroll
    for (int reg = 0; reg < 4; ++reg) { gci[reg] = __shfl(gcl, 16 * mb + 4 * quad + reg); bi[reg] = __shfl(betal, 16 * mb + 4 * quad + reg) * __shfl(rskl, 16 * mb + 4 * quad + reg); }
#pragma unroll
    for (int nb = 0; nb < 4; ++nb) {
      f32x4 dl = {0.f, 0.f, 0.f, 0.f};
      if (nb <= mb) {
#pragma unroll
        for (int kk = 0; kk < 4; ++kk) dl = __builtin_amdgcn_mfma_f32_16x16x32_bf16(kfrag[mb][kk], kfrag[nb][kk], dl, 0, 0, 0);
      }
      const int j = 16 * nb + r; const float gj = gcr[nb], rj = rskr[nb];
      f32x4 lv;
#pragma unroll
      for (int reg = 0; reg < 4; ++reg) { const int i = 16 * mb + 4 * quad + reg; lv[reg] = (nb <= mb && j < i) ? dl[reg] * __expf(fminf(gci[reg] - gj, 0.f)) * (bi[reg] * rj) : 0.f; }
      *(f32x4*)(T + j * TL_LD + 16 * mb + 4 * quad) = lv;
      __builtin_amdgcn_sched_barrier(0);
    }
  }
  RELAUNDER();
#pragma unroll 1
  for (int mb = 0; mb < 4; ++mb) {
    bf16x8 qf[4];
    float rsq;
    {
      float ss = 0.f;
#pragma unroll
      for (int kk = 0; kk < 4; ++kk) { f32x4 wt[4][2]; load_w(0, kk, wt); float f[8]; conv_frag(0, mb, kk, wt, f); qf[kk] = pack8(f, 1.f);
#pragma unroll
        for (int c = 0; c < 8; ++c) ss += f[c] * f[c];
        if (kk == 3) { asm volatile("" ::: "memory"); __builtin_amdgcn_sched_barrier(0); } }
      ss += __shfl_xor(ss, 16); ss += __shfl_xor(ss, 32);
      rsq = rsqrtf(ss + EPS) * 0.08838834764831845f;
    }
    {
      const float sq = __expf(__shfl(gcl, 16 * mb + r)) * rsq;
      bf16_t* dq = QDg + (size_t)chunk * 8192 + (16 * mb + r) * 128;
#pragma unroll
      for (int kk = 0; kk < 4; ++kk) { const u32x4 qd = scale8(qf[kk], sq);
        if (DNW_OUT & 4) { *(u32x2*)(dq + permcol(32 * kk + 8 * quad)) = (u32x2){qd[0], qd[1]}; *(u32x2*)(dq + permcol(32 * kk + 8 * quad + 4)) = (u32x2){qd[2], qd[3]}; } }
    }
    float gci[4], rqi[4];
#pragma unroll
    for (int reg = 0; reg < 4; ++reg) { gci[reg] = __shfl(gcl, 16 * mb + 4 * quad + reg); rqi[reg] = __shfl(rsq, 4 * quad + reg); }
    bf16_t* qrow = QAg + (size_t)chunk * 4096 + (16 * mb + 4 * quad) * 64;
#pragma unroll
    for (int nb = 0; nb < 4; ++nb) {
      f32x4 dq = {0.f, 0.f, 0.f, 0.f};
#pragma unroll
      for (int kk = 0; kk < 4; ++kk) dq = __builtin_amdgcn_mfma_f32_16x16x32_bf16(qf[kk], kfrag[nb][kk], dq, 0, 0, 0);
      const int j = 16 * nb + r; const float gj = gcr[nb], rj = rskr[nb];
#pragma unroll
      for (int reg = 0; reg < 4; ++reg) {
        const int i = 16 * mb + 4 * quad + reg;
        const float qv = (j <= i) ? dq[reg] * __expf(fminf(gci[reg] - gj, 0.f)) * (rqi[reg] * rj) : 0.f;
        if (DNW_OUT & 16) qrow[reg * 64 + permcol(j)] = (bf16_t)(pk_bf16(qv, 0.f) & 0xffff);
      }
    }
  }
  wave_lds_sync();
  if (DNW_STOP == 2) { if (kfrag[0][0][0] == 12345) GL[0] = 1.f; return; }
  RELAUNDER();
  {
    const int c = lane;
#pragma unroll 1
    for (int ib = 0; ib < (DBG_NOSOLVE ? 0 : 4); ++ib) {
      float rr[16];
#pragma unroll
      for (int ii = 0; ii < 16; ++ii) rr[ii] = (16 * ib + ii == c) ? 1.f : 0.f;
#pragma unroll 2
      for (int j = 0; j < 16 * ib; ++j) {
        const float xj = T[c * TL_LD + j];
        const f32x4* lp = (const f32x4*)(T + j * TL_LD + 16 * ib);
#pragma unroll
        for (int q = 0; q < 4; ++q) { const f32x4 l = lp[q];
#pragma unroll
          for (int e = 0; e < 4; ++e) rr[4 * q + e] -= l[e] * xj; }
      }
#pragma unroll
      for (int jj = 0; jj < 16; ++jj) {
        const float xj = rr[jj];
        const f32x4* lp = (const f32x4*)(T + (16 * ib + jj) * TL_LD + 16 * ib);
#pragma unroll
        for (int q = (jj + 1) / 4; q < 4; ++q) { const f32x4 l = lp[q];
#pragma unroll
          for (int e = 0; e < 4; ++e) if (4 * q + e > jj) rr[4 * q + e] -= l[e] * xj; }
      }
      wave_lds_sync();
#pragma unroll
      for (int q = 0; q < 4; ++q) *(f32x4*)(T + c * TL_LD + 16 * ib + 4 * q) = (f32x4){rr[4 * q], rr[4 * q + 1], rr[4 * q + 2], rr[4 * q + 3]};
      wave_lds_sync();
    }
  }
  if (DNW_STOP == 3) { if (kfrag[0][0][0] == 12345) GL[0] = 1.f; return; }
  RELAUNDER();
  bf16x8 tfrag[4][2];
#pragma unroll
  for (int mb = 0; mb < 4; ++mb)
#pragma unroll
    for (int k2 = 0; k2 < 2; ++k2) {
      float v[8];
#pragma unroll
      for (int jj = 0; jj < 8; ++jj) v[jj] = T[(32 * k2 + 8 * quad + jj) * TL_LD + 16 * mb + r];
      tfrag[mb][k2] = pack8(v, 1.f);
      __builtin_amdgcn_sched_barrier(0);
    }
  wave_lds_sync();
#define i16q ((lane & 15) >> 2)
#define i16p (lane & 3)
  RELAUNDER();
#pragma unroll 1
  for (int kk = 0; kk < 4; ++kk) {
    f32x4 wt[4][2]; load_w(2, kk, wt);
#pragma unroll 4
    for (int mb = 0; mb < 4; ++mb) { float f[8]; conv_frag(2, mb, kk, wt, f);
      *(bf16x8*)(wl + img_off(16 * mb + r, 2 * kk + (quad >> 1)) + 16 * (quad & 1)) = pack8(f, __shfl(betal, 16 * mb + r)); }
  }
  wave_lds_sync();
#pragma unroll 1
  for (int cb = 0; cb < 8; ++cb) {
    bf16x8 bf[2];
    { const int t0 = 8 * quad + i16q; s16x4 x0, x1, x2, x3;
      tr_read4(wl_addr + img_off(t0, cb) + 8 * i16p, wl_addr + img_off(t0 + 4, cb) + 8 * i16p, wl_addr + img_off(t0 + 32, cb) + 8 * i16p, wl_addr + img_off(t0 + 36, cb) + 8 * i16p, x0, x1, x2, x3);
      bf[0] = __builtin_shufflevector(x0, x1, 0, 1, 2, 3, 4, 5, 6, 7); bf[1] = __builtin_shufflevector(x2, x3, 0, 1, 2, 3, 4, 5, 6, 7); }
#pragma unroll
    for (int mb = 0; mb < 4; ++mb) {
      f32x4 d = {0.f, 0.f, 0.f, 0.f};
#pragma unroll
      for (int k2 = 0; k2 < 2; ++k2) d = __builtin_amdgcn_mfma_f32_16x16x32_bf16(tfrag[mb][k2], bf[k2], d, 0, 0, 0);
      u32x2 o; o.x = pk_bf16_mfma(d[0], d[1]); o.y = pk_bf16_mfma(d[2], d[3]);
      if (DNW_OUT & 1) *(u32x2*)(Ug + (size_t)chunk * 8192 + (16 * cb + r) * 64 + 16 * mb + 4 * quad) = o;
    }
  }
  wave_lds_sync();
  if (DNW_STOP == 4) { if (kfrag[0][0][0] == 12345) GL[0] = 1.f; return; }
  RELAUNDER();
#pragma unroll
  for (int mb = 0; mb < 4; ++mb) { const float sc = betar[mb] * __expf(gcr[mb]) * rskr[mb];
#pragma unroll
    for (int kk = 0; kk < 4; ++kk) *(u32x4*)(wl + img_off(16 * mb + r, 2 * kk + (quad >> 1)) + 16 * (quad & 1)) = scale8(kfrag[mb][kk], sc);
    __builtin_amdgcn_sched_barrier(0); }
  wave_lds_sync();
#pragma unroll 1
  for (int cb = 0; cb < 8; ++cb) {
    bf16x8 af[2];
    { const int t0 = 8 * quad + i16q; s16x4 x0, x1, x2, x3;
      tr_read4(wl_addr + img_off(t0, cb) + 8 * i16p, wl_addr + img_off(t0 + 4, cb) + 8 * i16p, wl_addr + img_off(t0 + 32, cb) + 8 * i16p, wl_addr + img_off(t0 + 36, cb) + 8 * i16p, x0, x1, x2, x3);
      af[0] = __builtin_shufflevector(x0, x1, 0, 1, 2, 3, 4, 5, 6, 7); af[1] = __builtin_shufflevector(x2, x3, 0, 1, 2, 3, 4, 5, 6, 7); }
#pragma unroll
    for (int mb = 0; mb < 4; ++mb) {
      f32x4 d = {0.f, 0.f, 0.f, 0.f};
#pragma unroll
      for (int k2 = 0; k2 < 2; ++k2) d = __builtin_amdgcn_mfma_f32_16x16x32_bf16(af[k2], tfrag[mb][k2], d, 0, 0, 0);
      u32x2 o; o.x = pk_bf16_mfma(d[0], d[1]); o.y = pk_bf16_mfma(d[2], d[3]);
      if (DNW_OUT & 2) *(u32x2*)(Wg + (size_t)chunk * 8192 + (16 * mb + r) * 128 + permcol(16 * cb + 4 * quad)) = o;
    }
  }
  wave_lds_sync();
  RELAUNDER();
#pragma unroll
  for (int mb = 0; mb < 4; ++mb) { const float sk = __expf(glast - gcr[mb]) * rskr[mb];
#pragma unroll
    for (int kk = 0; kk < 4; ++kk) *(u32x4*)(wl + img_off(16 * mb + r, 2 * kk + (quad >> 1)) + 16 * (quad & 1)) = scale8(kfrag[mb][kk], sk);
    __builtin_amdgcn_sched_barrier(0); }
  wave_lds_sync();
#pragma unroll 1
  for (int cb = 0; cb < 8; ++cb)
    {
      s16x4 v0, v1, v2, v3; const int t0 = 4 * quad + i16q;
      tr_read4(wl_addr + img_off(t0, cb) + 8 * i16p, wl_addr + img_off(t0 + 16, cb) + 8 * i16p, wl_addr + img_off(t0 + 32, cb) + 8 * i16p, wl_addr + img_off(t0 + 48, cb) + 8 * i16p, v0, v1, v2, v3);
      bf16_t* kt = KTg + (size_t)chunk * 8192 + (16 * cb + r) * 64;
      if (DNW_OUT & 8) { *(s16x4*)(kt + permcol(4 * quad)) = v0; *(s16x4*)(kt + permcol(16 + 4 * quad)) = v1; *(s16x4*)(kt + permcol(32 + 4 * quad)) = v2; *(s16x4*)(kt + permcol(48 + 4 * quad)) = v3; }
    }
  wave_lds_sync();
}
#undef r
#undef quad
#undef RELAUNDER
#undef i16q
#undef i16p

constexpr int VS_LD = 136;
DI void sb_unit(const Params& p, int unit, bf16_t* vl) {
  const int TIDX = launder_tid();
  char* ws = p.ws;
  const bf16_t* proj = (const bf16_t*)(ws + OFF_PROJ);
  bf16_t* mix = (bf16_t*)(ws + OFF_A);
  const int lane = TIDX & 63, r = lane & 31, hh = lane >> 5;
  const int b = unit >> 10, h = (unit >> 7) & 7, qb = unit & 127;
  const size_t rowbase = (size_t)b * SEQ;
  const int t0 = qb * 32;
  bf16x8 qf[8];
#pragma unroll
  for (int kk = 0; kk < 8; ++kk) qf[kk] = *(const bf16x8*)(proj + (rowbase + t0 + r) * PROJ_N + h * 128 + 16 * kk + 8 * hh);
  bf16x8 uf[2];
#pragma unroll
  for (int st = 0; st < 2; ++st)
#pragma unroll
    for (int j = 0; j < 8; ++j) { const int key = 16 * st + 8 * (j >> 2) + 4 * hh + (j & 3); uf[st][j] = (short)(key >= r ? 0x3F80 : 0); }
  float carry = 0.f;
  f32x16 o[4];
#pragma unroll
  for (int db = 0; db < 4; ++db)
#pragma unroll
    for (int i = 0; i < 16; ++i) o[db][i] = 0.f;
  const float scale = 0.08838834764831845f;
  for (int kb = qb; kb >= 0; --kb) {
    const int s0 = kb * 32;
#pragma unroll
    for (int i = 0; i < 8; ++i) { const int idx = lane + 64 * i, key = idx >> 4, c16 = idx & 15;
      *(u32x4*)(vl + key * VS_LD + c16 * 8) = *(const u32x4*)(proj + (rowbase + s0 + key) * PROJ_N + 2048 + h * 128 + c16 * 8); }
    f32x16 z;
#pragma unroll
    for (int i = 0; i < 16; ++i) z[i] = 0.f;
#pragma unroll
    for (int kk = 0; kk < 8; ++kk) {
      const bf16x8 kf = *(const bf16x8*)(proj + (rowbase + s0 + r) * PROJ_N + 1024 + h * 128 + 16 * kk + 8 * hh);
      z = __builtin_amdgcn_mfma_f32_32x32x16_bf16(kf, qf[kk], z, 0, 0, 0);
    }
    float sp[16]; bool valid[16];
#pragma unroll
    for (int i = 0; i < 16; ++i) {
      const int key = (i & 3) + 8 * (i >> 2) + 4 * hh;
      z[i] *= scale;
      valid[i] = (kb < qb) || (key < r);
      sp[i] = valid[i] ? softplusf_(z[i]) : 0.f;
    }
    f32x16 ct;
#pragma unroll
    for (int i = 0; i < 16; ++i) ct[i] = carry;
#pragma unroll
    for (int st = 0; st < 2; ++st) {
      u32x4 hi, lo;
#pragma unroll
      for (int j2 = 0; j2 < 4; ++j2) {
        const float a = sp[8 * st + 2 * j2], c = sp[8 * st + 2 * j2 + 1];
        const unsigned hp = pk_bf16(a, c);
        hi[j2] = hp; lo[j2] = pk_bf16(a - bflo(hp), c - bfhi(hp));
      }
      ct = __builtin_amdgcn_mfma_f32_32x32x16_bf16(uf[st], __builtin_bit_cast(bf16x8, hi), ct, 0, 0, 0);
      ct = __builtin_amdgcn_mfma_f32_32x32x16_bf16(uf[st], __builtin_bit_cast(bf16x8, lo), ct, 0, 0, 0);
    }
    bf16x8 pa[2];
#pragma unroll
    for (int st = 0; st < 2; ++st) {
      u32x4 t;
#pragma unroll
      for (int j2 = 0; j2 < 4; ++j2) {
        const int i0 = 8 * st + 2 * j2;
        const float a = valid[i0] ? __expf(z[i0] - ct[i0]) : 0.f, c = valid[i0 + 1] ? __expf(z[i0 + 1] - ct[i0 + 1]) : 0.f;
        t[j2] = pk_bf16(a, c);
      }
      pa[st] = __builtin_bit_cast(bf16x8, t);
    }
    carry = __shfl(ct[0], r);
    wave_lds_sync();
#pragma unroll
    for (int db = 0; db < 4; ++db)
#pragma unroll
      for (int st = 0; st < 2; ++st) {
        bf16x8 vf;
#pragma unroll
        for (int j = 0; j < 8; ++j) { const int key = 16 * st + 8 * (j >> 2) + 4 * hh + (j & 3); vf[j] = (short)vl[key * VS_LD + 32 * db + r]; }
        o[db] = __builtin_amdgcn_mfma_f32_32x32x16_bf16(vf, pa[st], o[db], 0, 0, 0);
      }
    wave_lds_sync();
    if (__all(carry > 104.f)) break;
  }
  float ss = 0.f;
#pragma unroll
  for (int db = 0; db < 4; ++db)
#pragma unroll
    for (int i = 0; i < 16; ++i) ss += o[db][i] * o[db][i];
  ss += __shfl_xor(ss, 32);
  const float rs = rsqrtf(ss * (1.f / 128.f) + EPS);
#pragma unroll
  for (int db = 0; db < 4; ++db)
#pragma unroll
    for (int g4 = 0; g4 < 4; ++g4) {
      const int d = 32 * db + 8 * g4 + 4 * hh;
      const f32x4 gn = *(const f32x4*)(p.sb_gain + d);
      u32x2 v; v.x = pk_bf16(o[db][4 * g4] * rs * gn[0], o[db][4 * g4 + 1] * rs * gn[1]); v.y = pk_bf16(o[db][4 * g4 + 2] * rs * gn[2], o[db][4 * g4 + 3] * rs * gn[3]);
      *(u32x2*)(vl + r * VS_LD + d) = v;
    }
  wave_lds_sync();
#pragma unroll
  for (int i = 0; i < 8; ++i) { const int idx = lane + 64 * i, q = idx >> 4, c16 = idx & 15;
    *(u32x4*)(mix + (rowbase + t0 + q) * D_MODEL + h * 128 + c16 * 8) = *(const u32x4*)(vl + q * VS_LD + c16 * 8); }
  wave_lds_sync();
}

DI bf16x8 pack_rows(const f32x4& a, const f32x4& b) { u32x4 t; t[0] = pk_bf16_mfma(a[0], a[1]); t[1] = pk_bf16_mfma(a[2], a[3]); t[2] = pk_bf16_mfma(b[0], b[1]); t[3] = pk_bf16_mfma(b[2], b[3]); return __builtin_bit_cast(bf16x8, t); }
constexpr int SC_W = 0, SC_QD = 16384, SC_KT = 32768, SC_QA = 49152, SC_U = 57344, SC_BUF = 65536;
DI int swz256(int row, int ch) { return row * 256 + ((ch ^ (row & 15)) << 4); }
DI int swz128(int row, int ch) { return row * 128 + ((ch ^ ((row >> 1) & 7)) << 4); }
DI void dn_scan_block(const Params& p, int unit, char* smem) {
  const int TIDX = launder_tid();
  char* ws = p.ws;
  const bf16_t* Ug = (const bf16_t*)p.out;
  const bf16_t* Wg = Ug + (size_t)NCHUNK * 8192; const bf16_t* QDg = Wg + (size_t)NCHUNK * 8192; const bf16_t* KTg = QDg + (size_t)NCHUNK * 8192;
  const bf16_t* QAg = (const bf16_t*)(ws + OFF_QA);
  const float* GL = (const float*)(ws + OFF_GL);
  float* odn = (float*)(ws + OFF_ODN);
  const int bh = unit >> 1, half = unit & 1, b = bh >> 3, h = bh & 7;
  const int wave = TIDX >> 6, lane = TIDX & 63, r = lane & 15, quad = lane >> 4;
  const int e0 = half * 64 + wave * 16;
  const int lt = TIDX & 255;
#define SC_OFF(i) ((i) < 4 ? SC_W + swz256((lt + 256 * (i)) >> 4, (lt + 256 * (i)) & 15) : (i) < 8 ? SC_QD + swz256((lt + 256 * ((i) - 4)) >> 4, (lt + 256 * ((i) - 4)) & 15) : \
                    (i) < 12 ? SC_KT + swz128((lt + 256 * ((i) - 8)) >> 3, (lt + 256 * ((i) - 8)) & 7) : (i) < 14 ? SC_QA + swz128((lt + 256 * ((i) - 12)) >> 3, (lt + 256 * ((i) - 12)) & 7) : \
                    SC_U + swz128((lt + 256 * ((i) - 14)) >> 3, (lt + 256 * ((i) - 14)) & 7))
#define SC_SRC(i, c_) ((i) < 4 ? Wg + (c_) * 8192 + (lt + 256 * (i)) * 8 : (i) < 8 ? QDg + (c_) * 8192 + (lt + 256 * ((i) - 4)) * 8 : (i) < 12 ? KTg + (c_) * 8192 + (lt + 256 * ((i) - 8)) * 8 : \
                       (i) < 14 ? QAg + (c_) * 4096 + (lt + 256 * ((i) - 12)) * 8 : Ug + (c_) * 8192 + half * 4096 + (lt + 256 * ((i) - 14)) * 8)
#define SC_LOAD(st, chunk) do { const size_t c_ = (chunk); _Pragma("unroll") for (int i_ = 0; i_ < 16; ++i_) st[i_] = *(const u32x4*)(SC_SRC(i_, c_)); } while (0)
#define SC_STORE(st, buf) do { char* b_ = smem + (buf) * SC_BUF; _Pragma("unroll") for (int i_ = 0; i_ < 16; ++i_) *(u32x4*)(b_ + SC_OFF(i_)) = st[i_]; } while (0)
  f32x4 S[8];
#pragma unroll
  for (int i = 0; i < 8; ++i) S[i] = (f32x4){0.f, 0.f, 0.f, 0.f};
  const size_t chunk0 = (size_t)bh * 64;
  const float eglv = __expf(GL[chunk0 + lane]);
  auto compute = [&](int n) {
    if (wave < 4) {
      const char* B = smem + (n & 1) * SC_BUF;
      bf16x8 Sb[4];
#pragma unroll
      for (int kk = 0; kk < 4; ++kk) Sb[kk] = pack_rows(S[2 * kk], S[2 * kk + 1]);
      f32x4 vn[4];
#pragma unroll
      for (int tb = 0; tb < 4; ++tb) {
        f32x4 acc = {0.f, 0.f, 0.f, 0.f};
#pragma unroll
        for (int kk = 0; kk < 4; ++kk) acc = __builtin_amdgcn_mfma_f32_16x16x32_bf16(*(const bf16x8*)(B + SC_W + swz256(16 * tb + r, 4 * kk + quad)), Sb[kk], acc, 0, 0, 0);
        const u32x2 uu = *(const u32x2*)(B + SC_U + swz128(wave * 16 + r, 2 * tb + (quad >> 1)) + (quad & 1) * 8);
        vn[tb][0] = bflo(uu.x) - acc[0]; vn[tb][1] = bfhi(uu.x) - acc[1]; vn[tb][2] = bflo(uu.y) - acc[2]; vn[tb][3] = bfhi(uu.y) - acc[3];
      }
      bf16x8 Vb[2];
      Vb[0] = pack_rows(vn[0], vn[1]); Vb[1] = pack_rows(vn[2], vn[3]);
#pragma unroll
      for (int tb = 0; tb < 4; ++tb) {
        f32x4 acc = {0.f, 0.f, 0.f, 0.f};
#pragma unroll
        for (int kk = 0; kk < 4; ++kk) acc = __builtin_amdgcn_mfma_f32_16x16x32_bf16(*(const bf16x8*)(B + SC_QD + swz256(16 * tb + r, 4 * kk + quad)), Sb[kk], acc, 0, 0, 0);
#pragma unroll
        for (int kt = 0; kt < 2; ++kt) acc = __builtin_amdgcn_mfma_f32_16x16x32_bf16(*(const bf16x8*)(B + SC_QA + swz128(16 * tb + r, 4 * kt + quad)), Vb[kt], acc, 0, 0, 0);
#pragma unroll
        for (int reg = 0; reg < 4; ++reg) odn[((size_t)b * SEQ + n * 64 + 16 * tb + 4 * quad + reg) * 1024 + h * 128 + e0 + r] = acc[reg];
      }
      const float egl = __int_as_float(__builtin_amdgcn_readlane(__float_as_int(eglv), n));
#pragma unroll
      for (int mb = 0; mb < 8; ++mb) {
        f32x4 acc = S[mb] * egl;
#pragma unroll
        for (int kt = 0; kt < 2; ++kt) acc = __builtin_amdgcn_mfma_f32_16x16x32_bf16(*(const bf16x8*)(B + SC_KT + swz128(16 * mb + r, 4 * kt + quad)), Vb[kt], acc, 0, 0, 0);
        S[mb] = acc;
      }
    }
  };
  if (wave >= 4) {
    u32x4 sta[16], stb[16];
    SC_LOAD(sta, chunk0); SC_LOAD(stb, chunk0 + 1); SC_STORE(sta, 0);
    for (int n = 0; n < 64; n += 2) {
      __syncthreads();
      if (n + 2 < 64) SC_LOAD(sta, chunk0 + n + 2);
      SC_STORE(stb, 1);
      __syncthreads();
      if (n + 3 < 64) SC_LOAD(stb, chunk0 + n + 3);
      if (n + 2 < 64) SC_STORE(sta, 0);
    }
  } else {
    for (int n = 0; n < 64; n += 2) {
      __syncthreads();
      compute(n);
      __syncthreads();
      compute(n + 1);
    }
  }
#undef SC_LOAD
#undef SC_STORE
#undef SC_OFF
#undef SC_SRC
}

DI void dn_final_phase(const Params& p) {
  const int TIDX = launder_tid();
  char* ws = p.ws;
  const float* odn = (const float*)(ws + OFF_ODN);
  const bf16_t* proj = (const bf16_t*)(ws + OFF_PROJ);
  bf16_t* mix = (bf16_t*)(ws + OFF_A);
  const int wave = TIDX >> 6, lane = TIDX & 63;
  const int dloc = (lane & 7) * 16;
  f32x4 gn[4];
#pragma unroll
  for (int i = 0; i < 4; ++i) gn[i] = *(const f32x4*)(p.dn_gain + dloc + 4 * i);
  for (int row = blockIdx.x * 8 + wave; row < NTOK; row += gridDim.x * 8) {
    f32x4 v[4]; float ss = 0.f;
#pragma unroll
    for (int i = 0; i < 4; ++i) { v[i] = *(const f32x4*)(odn + (size_t)row * 1024 + lane * 16 + 4 * i); ss += v[i][0] * v[i][0] + v[i][1] * v[i][1] + v[i][2] * v[i][2] + v[i][3] * v[i][3]; }
    ss += __shfl_xor(ss, 1); ss += __shfl_xor(ss, 2); ss += __shfl_xor(ss, 4);
    const float rs = rsqrtf(ss * (1.f / 128.f) + EPS);
    const u32x4 z0 = *(const u32x4*)(proj + (size_t)row * PROJ_N + 6144 + lane * 16), z1 = *(const u32x4*)(proj + (size_t)row * PROJ_N + 6144 + lane * 16 + 8);
    u32x4 o0, o1;
#pragma unroll
    for (int i = 0; i < 4; ++i) {
      const unsigned zz = i < 2 ? z0[2 * i] : z1[2 * (i - 2)], zz2 = i < 2 ? z0[2 * i + 1] : z1[2 * (i - 2) + 1];
      const float a = v[i][0] * rs * gn[i][0] * siluf_(bflo(zz)), c = v[i][1] * rs * gn[i][1] * siluf_(bfhi(zz));
      const float d = v[i][2] * rs * gn[i][2] * siluf_(bflo(zz2)), e = v[i][3] * rs * gn[i][3] * siluf_(bfhi(zz2));
      if (i < 2) { o0[2 * i] = pk_bf16(a, c); o0[2 * i + 1] = pk_bf16(d, e); } else { o1[2 * (i - 2)] = pk_bf16(a, c); o1[2 * (i - 2) + 1] = pk_bf16(d, e); }
    }
    *(u32x4*)(mix + (size_t)row * D_MODEL + 1024 + lane * 16) = o0; *(u32x4*)(mix + (size_t)row * D_MODEL + 1024 + lane * 16 + 8) = o1;
  }
}

DI void rows_mid_phase(const Params& p) {
  const int TIDX = launder_tid();
  char* ws = p.ws;
  const bf16_t* m = (const bf16_t*)(ws + OFF_M);
  bf16_t* hn = (bf16_t*)(ws + OFF_A);
  const int wave = TIDX >> 6, lane = TIDX & 63;
  for (int row = blockIdx.x * 8 + wave; row < NTOK; row += gridDim.x * 8) {
    f32x4 v[8]; float ss = 0.f;
#pragma unroll
    for (int i = 0; i < 8; ++i) { const u32x2 q = *(const u32x2*)(m + (size_t)row * D_MODEL + 4 * (lane + 64 * i)); v[i] = (f32x4){bflo(q.x), bfhi(q.x), bflo(q.y), bfhi(q.y)}; ss += v[i][0] * v[i][0] + v[i][1] * v[i][1] + v[i][2] * v[i][2] + v[i][3] * v[i][3]; }
    ss = wave_sum(ss);
    const float rs = rsqrtf(ss * (1.f / D_MODEL) + EPS);
    float s2 = 0.f;
#pragma unroll
    for (int i = 0; i < 8; ++i) {
      const f32x4 g = *(const f32x4*)(p.ln_mix_post + 4 * (lane + 64 * i)), xv = *(const f32x4*)(p.x + (size_t)row * D_MODEL + 4 * (lane + 64 * i));
      v[i] = xv + v[i] * rs * g;
      s2 += v[i][0] * v[i][0] + v[i][1] * v[i][1] + v[i][2] * v[i][2] + v[i][3] * v[i][3];
    }
    s2 = wave_sum(s2);
    const float rs2 = rsqrtf(s2 * (1.f / D_MODEL) + EPS);
#pragma unroll
    for (int i = 0; i < 8; ++i) {
      const f32x4 g = *(const f32x4*)(p.ln_ffn_pre + 4 * (lane + 64 * i));
      const f32x4 y = v[i] * rs2 * g;
      u32x2 o; o.x = pk_bf16(y[0], y[1]); o.y = pk_bf16(y[2], y[3]);
      *(u32x2*)(hn + (size_t)row * D_MODEL + 4 * (lane + 64 * i)) = o;
    }
  }
}
DI void rows_final_phase(const Params& p) {
  const int TIDX = launder_tid();
  char* ws = p.ws;
  const bf16_t* f = (const bf16_t*)(ws + OFF_F);
  const bf16_t* m = (const bf16_t*)(ws + OFF_M);
  const int wave = TIDX >> 6, lane = TIDX & 63;
  for (int row = blockIdx.x * 8 + wave; row < NTOK; row += gridDim.x * 8) {
    f32x4 hv[8]; float s1 = 0.f;
#pragma unroll
    for (int i = 0; i < 8; ++i) { const u32x2 q = *(const u32x2*)(m + (size_t)row * D_MODEL + 4 * (lane + 64 * i)); hv[i] = (f32x4){bflo(q.x), bfhi(q.x), bflo(q.y), bfhi(q.y)}; s1 += hv[i][0] * hv[i][0] + hv[i][1] * hv[i][1] + hv[i][2] * hv[i][2] + hv[i][3] * hv[i][3]; }
    s1 = wave_sum(s1);
    const float rs1 = rsqrtf(s1 * (1.f / D_MODEL) + EPS);
#pragma unroll
    for (int i = 0; i < 8; ++i) {
      const f32x4 g = *(const f32x4*)(p.ln_mix_post + 4 * (lane + 64 * i)), xv = *(const f32x4*)(p.x + (size_t)row * D_MODEL + 4 * (lane + 64 * i));
      hv[i] = xv + hv[i] * rs1 * g;
    }
    f32x4 v[8]; float ss = 0.f;
#pragma unroll
    for (int i = 0; i < 8; ++i) { const u32x2 q = *(const u32x2*)(f + (size_t)row * D_MODEL + 4 * (lane + 64 * i)); v[i] = (f32x4){bflo(q.x), bfhi(q.x), bflo(q.y), bfhi(q.y)}; ss += v[i][0] * v[i][0] + v[i][1] * v[i][1] + v[i][2] * v[i][2] + v[i][3] * v[i][3]; }
    ss = wave_sum(ss);
    const float rs = rsqrtf(ss * (1.f / D_MODEL) + EPS);
#pragma unroll
    for (int i = 0; i < 8; ++i) {
      const f32x4 g = *(const f32x4*)(p.ln_ffn_post + 4 * (lane + 64 * i));
      *(f32x4*)(p.out + (size_t)row * D_MODEL + 4 * (lane + 64 * i)) = hv[i] + v[i] * rs * g;
    }
  }
}

DI void fast_grid_barrier(unsigned* bar, unsigned k) {
  asm volatile("s_waitcnt vmcnt(0) lgkmcnt(0)" ::: "memory");
  __syncthreads();
  if (threadIdx.x == 0) {
    const unsigned g = blockIdx.x & 7u, per_group = gridDim.x >> 3;
    unsigned* sub = bar + 64 * (1 + g); unsigned* gen = bar + 64 * (9 + g); unsigned* top = bar;
    __builtin_amdgcn_fence(__ATOMIC_RELEASE, "agent");
    asm volatile("s_waitcnt vmcnt(0)" ::: "memory");
    const unsigned old = __hip_atomic_fetch_add(sub, 1u, __ATOMIC_RELAXED, __HIP_MEMORY_SCOPE_AGENT);
    if (old + 1u == k * per_group) {
      __hip_atomic_fetch_add(top, 1u, __ATOMIC_RELAXED, __HIP_MEMORY_SCOPE_AGENT);
      while (__hip_atomic_load(top, __ATOMIC_RELAXED, __HIP_MEMORY_SCOPE_AGENT) < 8u * k) __builtin_amdgcn_s_sleep(2);
      __hip_atomic_store(gen, k, __ATOMIC_RELAXED, __HIP_MEMORY_SCOPE_AGENT);
    } else {
      while (__hip_atomic_load(gen, __ATOMIC_RELAXED, __HIP_MEMORY_SCOPE_AGENT) < k) __builtin_amdgcn_s_sleep(4);
    }
    __builtin_amdgcn_fence(__ATOMIC_ACQUIRE, "agent");
    asm volatile("s_waitcnt vmcnt(0)" ::: "memory");
  }
  __syncthreads();
}
#define CAS __attribute__((address_space(4)))
DI Params load_params() {
#if !defined(__HIP_DEVICE_COMPILE__)
  return Params{};
#else
  const CAS char* base = (const CAS char*)__builtin_amdgcn_kernarg_segment_ptr();
  asm volatile("" : "+s"(base));
  return *(const CAS Params*)base;
#endif
}
#ifndef ONLY_PHASE
#define ONLY_PHASE -1
#endif
#define PH_EN(n) (ONLY_PHASE < 0 || ONLY_PHASE == (n))
__global__ void __launch_bounds__(NTHREADS) fwd_megakernel(Params pk) {
  extern __shared__ __attribute__((aligned(16))) char smem[];
  cg::grid_group grid = cg::this_grid();
#ifndef PROBE_SB
#define PROBE_SB 1
#endif
#ifndef PROBE_PHASE
#define PROBE_PHASE -1
#endif
#define PHASE(n) if (PH_EN(n) && pk.phase_begin <= (n) && (n) < pk.phase_end) for (int rep_ = 0; rep_ < ((n) == PROBE_PHASE ? 2 : 1); ++rep_)
#define SYNC(n) if ((n) > pk.phase_begin && rep_ == 0) { fast_grid_barrier((unsigned*)(pk.ws + OFF_BAR), (unsigned)((n) - pk.phase_begin)); } if (rep_ > 0) __syncthreads(); const Params p = load_params(); char* ws = p.ws; (void)ws
  if (pk.phase_begin > 1000) grid.sync();
  PHASE(0) { SYNC(0); prep_phase(p, smem); }
  PHASE(1) { SYNC(1); gemm_phase<0>(p, (const bf16_t*)(ws + OFF_A), (const bf16_t*)(ws + OFF_WINT), NTOK, PROJ_N, 2048, ws + OFF_PROJ, nullptr, smem); }
  PHASE(2) { SYNC(2);
#if DN_V1
    for (int c = blockIdx.x; c < NCHUNK; c += gridDim.x) dn_chunk(p, c, smem);
    __syncthreads();
#endif
#if DN_V1 != 1
    { const int wave = launder_tid() >> 6;
      for (int c = blockIdx.x * 8 + wave; c < NCHUNK; c += gridDim.x * 8) dn_chunk_wave(p, c, smem); }
#endif
  }
  PHASE(3) { SYNC(3); const int TIDX = launder_tid();
    for (int u = blockIdx.x; u < 64; u += gridDim.x) { dn_scan_block(p, u, smem); __syncthreads(); }
    unsigned* qctr = (unsigned*)(ws + OFF_QCTR);
    const int wave = TIDX >> 6;
    bf16_t* vl = (bf16_t*)(smem + 64) + wave * (32 * VS_LD);
    constexpr int SB_UNITS = BATCH * 8 * 128 / 8;
    for (;;) {
      __syncthreads();
      if (TIDX == 0) *(volatile unsigned*)smem = atomicAdd(qctr, 1u);
      __syncthreads();
      const unsigned item = *(volatile unsigned*)smem;
      if (item >= (unsigned)(SB_UNITS + CONV_UNITS)) break;
      if (item < (unsigned)SB_UNITS) sb_unit(p, (int)item * 8 + wave, vl);
      else { __syncthreads(); convert_unit(p, (int)item - SB_UNITS, smem); }
    }
  }
  PHASE(4) { SYNC(4); dn_final_phase(p); }
  PHASE(5) { SYNC(5); gemm_phase<1>(p, (const bf16_t*)(ws + OFF_A), (const bf16_t*)(ws + OFF_WOUTT), NTOK, 2048, 2048, ws + OFF_M, nullptr, smem); }
  PHASE(6) { SYNC(6); rows_mid_phase(p); }
  PHASE(7) { SYNC(7); gemm_phase<2>(p, (const bf16_t*)(ws + OFF_A), (const bf16_t*)(ws + OFF_WUPT), NTOK, UP_N, 2048, ws + OFF_ACT, (bf16_t*)(ws + OFF_HALO), smem); }
  PHASE(8) { SYNC(8); ffn_fix_phase(p, (const bf16_t*)(ws + OFF_HALO), (bf16_t*)(ws + OFF_ACT)); }
  PHASE(9) { SYNC(9); gemm_phase<1>(p, (const bf16_t*)(ws + OFF_ACT), (const bf16_t*)(ws + OFF_WDOWNT), NTOK, 2048, D_FF, ws + OFF_F, nullptr, smem); }
  PHASE(10) { SYNC(10);
#ifdef PROBE_SYNCS
    for (int i_ = 0; i_ < 10; ++i_) fast_grid_barrier((unsigned*)(pk.ws + OFF_BAR), (unsigned)(10 + i_));
#endif
    rows_final_phase(p); }
}

constexpr int NPHASES = 11;
#ifndef MK_SINGLE_LAUNCH
#define MK_SINGLE_LAUNCH 1
#endif

extern "C" void kernel_launch(void* const* d_in, const int* in_sizes, int n_in, void* d_out, int out_size, void* d_ws, size_t ws_size, hipStream_t stream) {
  static int grid_blocks = 0;
  if (!grid_blocks) {
    hipFuncSetAttribute((const void*)fwd_megakernel, hipFuncAttributeMaxDynamicSharedMemorySize, LDS_BYTES);
    int dev = 0, cus = 0, per_cu = 0;
    hipGetDevice(&dev);
    hipDeviceGetAttribute(&cus, hipDeviceAttributeMultiprocessorCount, dev);
    hipOccupancyMaxActiveBlocksPerMultiprocessor(&per_cu, fwd_megakernel, NTHREADS, LDS_BYTES);
    if (per_cu < 1) per_cu = 1;
    if (per_cu > 1) per_cu = 1;
    grid_blocks = cus * per_cu;
    if (grid_blocks > 256) grid_blocks = 256;
    grid_blocks &= ~7;
  }
  Params p{};
  p.x = (const float*)d_in[0]; p.w_in = (const float*)d_in[1]; p.sb_gain = (const float*)d_in[2]; p.dn_conv_w = (const float*)d_in[3];
  p.dn_a_log = (const float*)d_in[4]; p.dn_dt_bias = (const float*)d_in[5]; p.dn_gain = (const float*)d_in[6]; p.w_out = (const float*)d_in[7];
  p.ln_mix_pre = (const float*)d_in[8]; p.ln_mix_post = (const float*)d_in[9]; p.w_up = (const float*)d_in[10]; p.ffn_conv_w = (const float*)d_in[11];
  p.ffn_conv_b = (const float*)d_in[12]; p.w_down = (const float*)d_in[13]; p.ln_ffn_pre = (const float*)d_in[14]; p.ln_ffn_post = (const float*)d_in[15];
  p.out = (float*)d_out; p.ws = (char*)d_ws;
#if MK_SINGLE_LAUNCH
  p.phase_begin = 0; p.phase_end = NPHASES;
  hipMemsetAsync((char*)d_ws + OFF_BAR, 0, 17 * 256, stream);
  void* args[] = {&p};
  hipError_t e = hipLaunchCooperativeKernel((const void*)fwd_megakernel, dim3(grid_blocks), dim3(NTHREADS), args, LDS_BYTES, stream);
  if (e != hipSuccess) fprintf(stderr, "cooperative launch failed: %s (grid %d)\n", hipGetErrorString(e), grid_blocks);
#else
  for (int ph = 0; ph < NPHASES; ++ph) {
    p.phase_begin = ph; p.phase_end = ph + 1;
    hipLaunchKernelGGL(fwd_megakernel, dim3(grid_blocks), dim3(NTHREADS), LDS_BYTES, stream, p);
  }
#endif
}
```

```cpp
#include <hip/hip_runtime.h>
#include <hip/hip_cooperative_groups.h>
#include <cstdio>
namespace cg = cooperative_groups;

typedef unsigned short bf16_t;
typedef short bf16x8 __attribute__((ext_vector_type(8)));
typedef float f32x4 __attribute__((ext_vector_type(4)));
typedef float f32x16 __attribute__((ext_vector_type(16)));
typedef unsigned u32x4 __attribute__((ext_vector_type(4)));
typedef unsigned u32x2 __attribute__((ext_vector_type(2)));
#define DI __device__ __forceinline__

constexpr int D_MODEL = 2048, BATCH = 4, SEQ = 4096, NTOK = BATCH * SEQ;
constexpr int PROJ_N = 7168;
constexpr int IN_COLS = 7184;
constexpr int D_FF = 5632, UP_N = 2 * D_FF;
constexpr int NCHUNK = BATCH * 8 * 64;
constexpr float EPS = 1e-6f;
constexpr int NTHREADS = 512;
constexpr int CS_LD = 264;
constexpr int LDS_BYTES = 163840;
#ifndef DN_V1
#define DN_V1 0
#endif

constexpr size_t MiB = 1024ull * 1024ull;
constexpr size_t OFF_WUPT = 0, OFF_WDOWNT = 44 * MiB, OFF_A = 66 * MiB, OFF_WINT = 130 * MiB, OFF_WOUTT = 158 * MiB,
                 OFF_EXT = 166 * MiB, OFF_GL = 167 * MiB, OFF_QCTR = 167 * MiB + 65536, OFF_BAR = 167 * MiB + 65536 + 1024, OFF_HALO = 168 * MiB, OFF_PROJ = 174 * MiB, OFF_QA = 398 * MiB,
                 OFF_ODN = 414 * MiB, OFF_M = 414 * MiB  , OFF_ACT = 174 * MiB, OFF_F = 350 * MiB;

struct Params {
  const float* x; const float* w_in; const float* sb_gain; const float* dn_conv_w; const float* dn_a_log; const float* dn_dt_bias;
  const float* dn_gain; const float* w_out; const float* ln_mix_pre; const float* ln_mix_post; const float* w_up; const float* ffn_conv_w;
  const float* ffn_conv_b; const float* w_down; const float* ln_ffn_pre; const float* ln_ffn_post;
  float* out; char* ws;
  int phase_begin, phase_end;
};

typedef float f32x2_t __attribute__((ext_vector_type(2)));
typedef __bf16 bf16x2_t __attribute__((ext_vector_type(2)));
DI unsigned pk_bf16_mfma(float lo, float hi) { const f32x2_t v = {lo, hi}; return __builtin_bit_cast(unsigned, __builtin_convertvector(v, bf16x2_t)); }
DI unsigned pk_bf16(float lo, float hi) { unsigned r; asm("v_cvt_pk_bf16_f32 %0, %1, %2" : "=v"(r) : "v"(lo), "v"(hi)); return r; }
DI float bf2f(bf16_t v) { return __uint_as_float(((unsigned)v) << 16); }
DI float bflo(unsigned v) { return __uint_as_float(v << 16); }
DI float bfhi(unsigned v) { return __uint_as_float(v & 0xffff0000u); }
DI float wave_sum(float v) {
#pragma unroll
  for (int o = 32; o >= 1; o >>= 1) v += __shfl_xor(v, o);
  return v;
}
DI float sigmoidf_(float x) { return __builtin_amdgcn_rcpf(1.f + __expf(-x)); }
DI float siluf_(float x) { return x * __builtin_amdgcn_rcpf(1.f + __expf(-x)); }
DI float softplusf_(float x) { return fmaxf(x, 0.f) + __logf(1.f + __expf(-fabsf(x))); }
DI float gelu_tanh(float x) { float u = 0.7978845608028654f * (x + 0.044715f * x * x * x); return x * __builtin_amdgcn_rcpf(1.f + __expf(-2.f * u)); }
DI int launder_tid() { int t = threadIdx.x; asm volatile("" : "+v"(t)); return t; }
DI void wave_lds_sync() { asm volatile("s_waitcnt lgkmcnt(0)" ::: "memory"); __builtin_amdgcn_wave_barrier(); }

constexpr int BM = 256, BK = 64, HALF = 128, NXCD = 8, WGM = 8, HT = HALF * BK;
DI int lds_byte(int r, int c) { int st = (r >> 4) * 2 + (c >> 5), rr = r & 15, cc = c & 31, ob = rr * 64 + cc * 2; return st * 1024 + (ob ^ (((ob >> 9) & 1) << 5)); }
DI void stage_rc(int b, int& R, int& C) { int st = b / 1024, sb = b % 1024, swz = sb ^ (((sb >> 9) & 1) << 5); R = (st >> 1) * 16 + swz / 64; C = (st & 1) * 32 + (swz % 64) / 2; }

#define LAS __attribute__((address_space(3)))
constexpr int HTB = HT * 2;
DI void gemm_tile(const bf16_t* __restrict__ A, const bf16_t* __restrict__ Bt, int K, int brow, int bcol, LAS unsigned char* lds, f32x4 (&acc)[2][2][4][2]) {
  const int TIDX = launder_tid();
  const int tid = TIDX, wid = __builtin_amdgcn_readfirstlane(tid >> 6), lane = tid & 63, wr = wid >> 2, wc = wid & 3, fr = lane & 15, fq = lane >> 4;
  const int nt = K / BK;
  unsigned voff[2];
#pragma unroll
  for (int i = 0; i < 2; ++i) { int R, C; stage_rc(tid * 16 + i * 8192, R, C); voff[i] = (unsigned)(R * K + C) * 2u; }
  const size_t kstep = (size_t)(BK * 2), hstep = (size_t)HALF * K * 2;
  const unsigned ldsw = (unsigned)wid * 1024u;
  const int aoff = lds_byte(wr * 64 + fr, fq * 8), boff = lds_byte(wc * 32 + fr, fq * 8);
#define SA(b, h) (((b) * 2 + (h)) * HTB)
#define SB(b, h) ((4 + (b) * 2 + (h)) * HTB)
#define STAGE(bufoff, gbase) do { _Pragma("unroll") for (int _i = 0; _i < 2; ++_i) \
    __builtin_amdgcn_global_load_lds((const unsigned*)((const char*)(gbase) + voff[_i]), (LAS unsigned*)(lds + (bufoff) + ldsw + _i * 8192), 16, 0, 0); } while (0)
#define LDA(dst, b, h) do { _Pragma("unroll") for (int m = 0; m < 4; ++m) _Pragma("unroll") for (int k = 0; k < 2; ++k) dst[m][k] = *(const LAS bf16x8*)(lds + SA(b, h) + aoff + m * 2048 + k * 1024); } while (0)
#define LDB(dst, b, h) do { _Pragma("unroll") for (int n = 0; n < 2; ++n) _Pragma("unroll") for (int k = 0; k < 2; ++k) dst[n][k] = *(const LAS bf16x8*)(lds + SB(b, h) + boff + n * 2048 + k * 1024); } while (0)
#define MMA(ai, bj, At, Bq) do { __builtin_amdgcn_s_setprio(1); _Pragma("unroll") for (int m = 0; m < 4; ++m) _Pragma("unroll") for (int n = 0; n < 2; ++n) _Pragma("unroll") for (int k = 0; k < 2; ++k) \
      acc[ai][bj][m][n] = __builtin_amdgcn_mfma_f32_16x16x32_bf16(Bq[n][k], At[m][k], acc[ai][bj][m][n], 0, 0, 0); \
    __builtin_amdgcn_s_setprio(0); } while (0)
#define WAIT_V(n) asm volatile("s_waitcnt vmcnt(" #n ")" ::: "memory")
#define WAIT_L(n) asm volatile("s_waitcnt lgkmcnt(" #n ")" ::: "memory")
#define BAR __builtin_amdgcn_s_barrier()
#define SCHED __builtin_amdgcn_sched_barrier(0)
#pragma unroll
  for (int a = 0; a < 2; ++a)
#pragma unroll
    for (int b = 0; b < 2; ++b)
#pragma unroll
      for (int m = 0; m < 4; ++m)
#pragma unroll
        for (int n = 0; n < 2; ++n) acc[a][b][m][n] = (f32x4){0.f, 0.f, 0.f, 0.f};
  bf16x8 At[4][2], B0[2][2], B1[2][2];
  const char* cA = (const char*)A + (size_t)brow * K * 2; const char* cB = (const char*)Bt + (size_t)bcol * K * 2;
  STAGE(SB(0, 0), cB); STAGE(SA(0, 0), cA); STAGE(SB(0, 1), cB + hstep); STAGE(SA(0, 1), cA + hstep);
  if (wr == 1) BAR;
  WAIT_V(4); BAR;
  STAGE(SB(1, 0), cB + kstep); STAGE(SA(1, 0), cA + kstep); STAGE(SB(1, 1), cB + hstep + kstep);
  WAIT_V(6); BAR;
  for (int t = 0; t < nt - 2; t += 2) {
    const char* a1 = cA + (size_t)(t + 1) * kstep;
    const char* a2 = cA + (size_t)(t + 2) * kstep; const char* b2 = cB + (size_t)(t + 2) * kstep;
    const char* a3 = a2 + kstep; const char* b3 = b2 + kstep;
    LDB(B0, 0, 0); SCHED; LDA(At, 0, 0); STAGE(SA(1, 1), a1 + hstep);
    WAIT_L(8); BAR; WAIT_L(0); MMA(0, 0, At, B0); BAR; SCHED;
    LDB(B1, 0, 1); STAGE(SB(0, 0), b2);
    BAR; WAIT_L(0); MMA(0, 1, At, B1); BAR;
    LDA(At, 0, 1); STAGE(SA(0, 0), a2);
    BAR; WAIT_L(0); MMA(1, 0, At, B0); BAR; SCHED;
    STAGE(SB(0, 1), b2 + hstep);
    WAIT_V(6); BAR; MMA(1, 1, At, B1); BAR;
    LDB(B0, 1, 0); SCHED; LDA(At, 1, 0); STAGE(SA(0, 1), a2 + hstep);
    WAIT_L(8); BAR; WAIT_L(0); MMA(0, 0, At, B0); BAR; SCHED;
    LDB(B1, 1, 1); STAGE(SB(1, 0), b3);
    BAR; WAIT_L(0); MMA(0, 1, At, B1); BAR;
    LDA(At, 1, 1); STAGE(SA(1, 0), a3);
    BAR; WAIT_L(0); MMA(1, 0, At, B0); BAR; SCHED;
    STAGE(SB(1, 1), b3 + hstep);
    WAIT_V(6); BAR; MMA(1, 1, At, B1); BAR;
  }
  { LDB(B0, 0, 0); LDA(At, 0, 0); STAGE(SA(1, 1), cA + (size_t)(nt - 1) * kstep + hstep);
    BAR; WAIT_L(0); MMA(0, 0, At, B0); BAR;
    LDB(B1, 0, 1); BAR; WAIT_L(0); MMA(0, 1, At, B1); BAR;
    LDA(At, 0, 1); WAIT_V(4); BAR; WAIT_L(0); MMA(1, 0, At, B0); MMA(1, 1, At, B1); BAR; }
  { LDB(B0, 1, 0); LDA(At, 1, 0); WAIT_V(2); BAR; WAIT_L(0); MMA(0, 0, At, B0); BAR;
    LDB(B1, 1, 1); WAIT_V(0); BAR; WAIT_L(0); MMA(0, 1, At, B1); BAR;
    LDA(At, 1, 1); BAR; WAIT_L(0); MMA(1, 0, At, B0); MMA(1, 1, At, B1); BAR; }
  if (wr == 0) BAR;
#undef SA
#undef SB
#undef STAGE
#undef LDA
#undef LDB
#undef MMA
}

DI void tile_of(int L, int nM, int nN, int& pm, int& pn) {
  const int nwg = nM * nN;
  int wgid = L; { const int q = nwg / NXCD, r = nwg % NXCD, xcd = wgid % NXCD, off = wgid / NXCD; wgid = (xcd < r ? xcd * (q + 1) : r * (q + 1) + (xcd - r) * q) + off; }
  const int nig = WGM * nN, gid = wgid / nig, fm = gid * WGM, gsz = (nM - fm) < WGM ? (nM - fm) : WGM;
  pm = fm + ((wgid % nig) % gsz); pn = (wgid % nig) / gsz;
}

DI void stage_c_bf16(const f32x4 (&acc)[2][2][4][2], bf16_t* Cs) {
  const int TIDX = launder_tid();
  const int wid = TIDX >> 6, lane = TIDX & 63, wr = wid >> 2, wc = wid & 3, fr = lane & 15, fq = lane >> 4;
#pragma unroll
  for (int ai = 0; ai < 2; ++ai)
#pragma unroll
    for (int bj = 0; bj < 2; ++bj)
#pragma unroll
      for (int m = 0; m < 4; ++m)
#pragma unroll
        for (int n = 0; n < 2; ++n) {
          const int row = ai * 128 + wr * 64 + m * 16 + fr, col = bj * 128 + wc * 32 + n * 16 + 4 * fq;
          u32x2 v; v.x = pk_bf16_mfma(acc[ai][bj][m][n][0], acc[ai][bj][m][n][1]); v.y = pk_bf16_mfma(acc[ai][bj][m][n][2], acc[ai][bj][m][n][3]);
          *(u32x2*)(Cs + row * CS_LD + col) = v;
        }
}

template <int EPI>
DI void gemm_phase(const Params& p, const bf16_t* A, const bf16_t* Bt, int M, int N, int K, void* outp, bf16_t* halo, char* smem) {
  const int TIDX = launder_tid();
  const int nM = M / BM, nN = N / BM, nwg = nM * nN;
  bf16_t* shm = (bf16_t*)smem;
  for (int L = blockIdx.x; L < nwg; L += gridDim.x) {
    int pm, pn; tile_of(L, nM, nN, pm, pn);
    const int brow = pm * BM, bcol = pn * BM;
    f32x4 acc[2][2][4][2];
    gemm_tile(A, Bt, K, brow, bcol, (LAS unsigned char*)smem, acc);
    if (EPI == 1) {
      bf16_t* O = (bf16_t*)outp;
      const int wid = TIDX >> 6, lane = TIDX & 63, wr = wid >> 2, wc = wid & 3, fr = lane & 15, fq = lane >> 4;
#pragma unroll
      for (int ai = 0; ai < 2; ++ai)
#pragma unroll
        for (int m = 0; m < 4; ++m) {
          bf16_t* rowp = O + (size_t)(brow + ai * 128 + wr * 64 + m * 16 + fr) * N + bcol + wc * 32 + 4 * fq;
#pragma unroll
          for (int bj = 0; bj < 2; ++bj)
#pragma unroll
            for (int n = 0; n < 2; ++n) { u32x2 v; v.x = pk_bf16_mfma(acc[ai][bj][m][n][0], acc[ai][bj][m][n][1]); v.y = pk_bf16_mfma(acc[ai][bj][m][n][2], acc[ai][bj][m][n][3]); *(u32x2*)(rowp + bj * 128 + n * 16) = v; }
        }
    } else {
      bf16_t* Cs = shm;
      stage_c_bf16(acc, Cs);
      __syncthreads();
      if (EPI == 0) {
        bf16_t* O = (bf16_t*)outp;
#pragma unroll 4
        for (int i = 0; i < 16; ++i) {
          const int id = TIDX + NTHREADS * i, row = id >> 5, ch = id & 31;
          const u32x4 v = *(const u32x4*)(Cs + row * CS_LD + ch * 8);
          *(u32x4*)(O + (size_t)(brow + row) * N + bcol + ch * 8) = v;
        }
      } else {
        bf16_t* ACT = (bf16_t*)outp;
        const int cgp = TIDX & 15, r0 = TIDX >> 4;
        const int gcol = pn * 128 + cgp * 8;
        float wg[3][8], wv[3][8], bg[8], bv[8];
#pragma unroll
        for (int k = 0; k < 3; ++k)
#pragma unroll
          for (int c = 0; c < 8; ++c) { wg[k][c] = p.ffn_conv_w[k * UP_N + gcol + c]; wv[k][c] = p.ffn_conv_w[k * UP_N + D_FF + gcol + c]; }
#pragma unroll
        for (int c = 0; c < 8; ++c) { bg[c] = p.ffn_conv_b[gcol + c]; bv[c] = p.ffn_conv_b[D_FF + gcol + c]; }
        const bool seq_start = (brow % SEQ) == 0;
        for (int i = 0; i < 8; ++i) {
          const int row = r0 + 32 * i;
          if (row < 2 && !seq_start) continue;
          float g[8], v[8];
#pragma unroll
          for (int c = 0; c < 8; ++c) { g[c] = bg[c]; v[c] = bv[c]; }
#pragma unroll
          for (int k = 0; k < 3; ++k) {
            const int rr = row - 2 + k;
            if (rr < 0) continue;
            const u32x4 gq = *(const u32x4*)(Cs + rr * CS_LD + cgp * 8);
            const u32x4 vq = *(const u32x4*)(Cs + rr * CS_LD + 128 + cgp * 8);
#pragma unroll
            for (int c2 = 0; c2 < 4; ++c2) {
              g[2 * c2] += wg[k][2 * c2] * bflo(gq[c2]); g[2 * c2 + 1] += wg[k][2 * c2 + 1] * bfhi(gq[c2]);
              v[2 * c2] += wv[k][2 * c2] * bflo(vq[c2]); v[2 * c2 + 1] += wv[k][2 * c2 + 1] * bfhi(vq[c2]);
            }
          }
          u32x4 o;
#pragma unroll
          for (int c2 = 0; c2 < 4; ++c2) o[c2] = pk_bf16(gelu_tanh(g[2 * c2]) * v[2 * c2], gelu_tanh(g[2 * c2 + 1]) * v[2 * c2 + 1]);
          *(u32x4*)(ACT + (size_t)(brow + row) * D_FF + gcol) = o;
        }
        if (TIDX < 128) {
          const int slot = TIDX >> 5, ch = TIDX & 31;
          const int row = slot < 2 ? slot : 252 + slot;
          *(u32x4*)(halo + ((size_t)(pm * 4 + slot) * UP_N) + pn * 256 + ch * 8) = *(const u32x4*)(Cs + row * CS_LD + ch * 8);
        }
      }
    }
    __syncthreads();
  }
}

DI void ffn_fix_phase(const Params& p, const bf16_t* halo, bf16_t* ACT) {
  const int TIDX = launder_tid();
  const int total = 64 * 2 * 44 * 16;
  for (int id = blockIdx.x * NTHREADS + TIDX; id < total; id += gridDim.x * NTHREADS) {
    const int cgp = id & 15; int t = id >> 4; const int pn = t % 44; t /= 44; const int rr = t & 1; const int pm = t >> 1;
    if ((pm & 15) == 0) continue;
    const int gcol = pn * 128 + cgp * 8;
    float g[8], v[8];
#pragma unroll
    for (int c = 0; c < 8; ++c) { g[c] = p.ffn_conv_b[gcol + c]; v[c] = p.ffn_conv_b[D_FF + gcol + c]; }
#pragma unroll
    for (int k = 0; k < 3; ++k) {
      const int r = rr - 2 + k;
      const bf16_t* src = r < 0 ? halo + (size_t)((pm - 1) * 4 + 4 + r) * UP_N : halo + (size_t)(pm * 4 + r) * UP_N;
      const u32x4 gq = *(const u32x4*)(src + pn * 256 + cgp * 8);
      const u32x4 vq = *(const u32x4*)(src + pn * 256 + 128 + cgp * 8);
#pragma unroll
      for (int c2 = 0; c2 < 4; ++c2) {
        g[2 * c2] += p.ffn_conv_w[k * UP_N + gcol + 2 * c2] * bflo(gq[c2]); g[2 * c2 + 1] += p.ffn_conv_w[k * UP_N + gcol + 2 * c2 + 1] * bfhi(gq[c2]);
        v[2 * c2] += p.ffn_conv_w[k * UP_N + D_FF + gcol + 2 * c2] * bflo(vq[c2]); v[2 * c2 + 1] += p.ffn_conv_w[k * UP_N + D_FF + gcol + 2 * c2 + 1] * bfhi(vq[c2]);
      }
    }
    u32x4 o;
#pragma unroll
    for (int c2 = 0; c2 < 4; ++c2) o[c2] = pk_bf16(gelu_tanh(g[2 * c2]) * v[2 * c2], gelu_tanh(g[2 * c2 + 1]) * v[2 * c2 + 1]);
    *(u32x4*)(ACT + (size_t)(pm * 256 + rr) * D_FF + gcol) = o;
  }
}

DI void transpose_group(const float* __restrict__ src, int ld_src, int K, int mode, bf16_t* __restrict__ dst, char* smem, int group) {
  const int TIDX = launder_tid();
  bf16_t* T = (bf16_t*)smem;
  const int gk = K / 256, tk4 = group % gk, tn = group / gk;
  int scol = tn * 64;
  if (mode == 1) { const int nt = tn >> 2, sub = tn & 3; scol = (sub < 2 ? 0 : D_FF) + nt * 128 + (sub & 1) * 64; }
  const int kq = TIDX >> 4, n4 = (TIDX & 15) * 4;
  f32x4 v[8];
#pragma unroll
  for (int i = 0; i < 8; ++i) v[i] = *(const f32x4*)(src + (size_t)(tk4 * 256 + kq + 32 * i) * ld_src + scol + n4);
#pragma unroll
  for (int i = 0; i < 8; ++i) {
    const int k = kq + 32 * (i & 1); bf16_t* Tq = T + (i >> 1) * (64 * 72);
    const unsigned a = pk_bf16(v[i][0], v[i][1]), b = pk_bf16(v[i][2], v[i][3]);
    Tq[(n4 + 0) * 72 + k] = (bf16_t)(a & 0xffff); Tq[(n4 + 1) * 72 + k] = (bf16_t)(a >> 16);
    Tq[(n4 + 2) * 72 + k] = (bf16_t)(b & 0xffff); Tq[(n4 + 3) * 72 + k] = (bf16_t)(b >> 16);
  }
  __syncthreads();
  { const int n = TIDX >> 3, k8 = (TIDX & 7) * 8;
#pragma unroll
    for (int q = 0; q < 4; ++q) *(u32x4*)(dst + (size_t)(tn * 64 + n) * K + tk4 * 256 + q * 64 + k8) = *(const u32x4*)(T + q * (64 * 72) + n * 72 + k8); }
  __syncthreads();
}
constexpr int CONV_UNITS = (256 + 1408 + 704) / 4;
DI void convert_unit(const Params& p, int unit, char* smem) {
  char* ws = p.ws;
#pragma unroll 1
  for (int q = 0; q < 4; ++q) {
    int g = unit * 4 + q;
    if (g < 256) transpose_group(p.w_out, 2048, 2048, 0, (bf16_t*)(ws + OFF_WOUTT), smem, g);
    else if (g < 256 + 1408) transpose_group(p.w_up, UP_N, 2048, 1, (bf16_t*)(ws + OFF_WUPT), smem, g - 256);
    else transpose_group(p.w_down, 2048, 5632, 0, (bf16_t*)(ws + OFF_WDOWNT), smem, g - 256 - 1408);
  }
}

DI void prep_phase(const Params& p, char* smem) {
  const int TIDX = launder_tid();
  char* ws = p.ws;
  if (blockIdx.x == 0 && TIDX == 0) *(unsigned*)(ws + OFF_QCTR) = 0u;
  for (int g = blockIdx.x; g < 8 * 112; g += gridDim.x) transpose_group(p.w_in, IN_COLS, 2048, 0, (bf16_t*)(ws + OFF_WINT), smem, g);
  __syncthreads();
  float* Wl = (float*)smem;
  for (int i = TIDX; i < 2048 * 16; i += NTHREADS) { const int d = i >> 4, j = i & 15; Wl[j * 2048 + d] = p.w_in[(size_t)d * IN_COLS + PROJ_N + j]; }
  __syncthreads();
  const int wave = TIDX >> 6, lane = TIDX & 63;
  bf16_t* xn = (bf16_t*)(ws + OFF_A);
  float* ext = (float*)(ws + OFF_EXT);
  for (int row0 = 2 * (blockIdx.x * 8 + wave); row0 < NTOK; row0 += 2 * gridDim.x * 8) {
    f32x4 v[2][8]; float ss[2] = {0.f, 0.f};
#pragma unroll
    for (int q = 0; q < 2; ++q)
#pragma unroll
      for (int i = 0; i < 8; ++i) { v[q][i] = __builtin_nontemporal_load((const f32x4*)(p.x + (size_t)(row0 + q) * D_MODEL + 4 * (lane + 64 * i))); ss[q] += v[q][i][0] * v[q][i][0] + v[q][i][1] * v[q][i][1] + v[q][i][2] * v[q][i][2] + v[q][i][3] * v[q][i][3]; }
#pragma unroll
    for (int q = 0; q < 2; ++q) {
      const float rs = rsqrtf(wave_sum(ss[q]) * (1.f / D_MODEL) + EPS);
#pragma unroll
      for (int i = 0; i < 8; ++i) {
        const f32x4 g = *(const f32x4*)(p.ln_mix_pre + 4 * (lane + 64 * i));
        v[q][i] = v[q][i] * rs * g;
        u32x2 o; o.x = pk_bf16(v[q][i][0], v[q][i][1]); o.y = pk_bf16(v[q][i][2], v[q][i][3]);
        *(u32x2*)(xn + (size_t)(row0 + q) * D_MODEL + 4 * (lane + 64 * i)) = o;
      }
    }
    float myv0 = 0.f, myv1 = 0.f;
#pragma unroll 1
    for (int j = 0; j < 16; ++j) {
      float a0 = 0.f, a1 = 0.f;
#pragma unroll
      for (int i = 0; i < 8; ++i) { const f32x4 w = *(const f32x4*)(Wl + j * 2048 + 4 * (lane + 64 * i));
        a0 += v[0][i][0] * w[0] + v[0][i][1] * w[1] + v[0][i][2] * w[2] + v[0][i][3] * w[3];
        a1 += v[1][i][0] * w[0] + v[1][i][1] * w[1] + v[1][i][2] * w[2] + v[1][i][3] * w[3]; }
      a0 = wave_sum(a0); a1 = wave_sum(a1);
      if (lane == j) { myv0 = a0; myv1 = a1; }
    }
    if (lane < 16) { ext[(size_t)row0 * 16 + lane] = myv0; ext[(size_t)(row0 + 1) * 16 + lane] = myv1; }
  }
}

DI int permcol(int c) { const int g = (c >> 2) & 7; const int ng = g < 4 ? 2 * g : 2 * (g - 4) + 1; return (c & ~31) | (ng << 2) | (c & 3); }
constexpr int QS_LD = 132, LM_LD = 68;
DI void dn_chunk(const Params& p, int chunk, char* smem) {
  const int TIDX = launder_tid();
  char* ws = p.ws;
  const bf16_t* proj = (const bf16_t*)(ws + OFF_PROJ);
  const float* ext = (const float*)(ws + OFF_EXT);
  bf16_t* Ug = (bf16_t*)p.out;
  bf16_t* Wg = Ug + (size_t)NCHUNK * 8192; bf16_t* QDg = Wg + (size_t)NCHUNK * 8192; bf16_t* KTg = QDg + (size_t)NCHUNK * 8192;
  bf16_t* QAg = (bf16_t*)(ws + OFF_QA);
  float* GL = (float*)(ws + OFF_GL);
  float* qs = (float*)smem; float* ks = qs + 64 * QS_LD; float* vs = ks + 64 * QS_LD; float* Lm = vs + 64 * QS_LD;
  float* gcs = Lm + 64 * LM_LD; float* betas = gcs + 64;
  const int bh = chunk >> 6, n = chunk & 63, b = bh >> 3, h = bh & 7;
  const int tid = TIDX, wave = tid >> 6, lane = tid & 63;
  const size_t tok0 = (size_t)b * SEQ + n * 64;
#ifndef PROBE_DN123
#define PROBE_DN123 1
#endif
  for (int rp_ = 0; rp_ < PROBE_DN123; ++rp_) {
  if (tid < 384) {
    const int cq = tid % 96, tg = tid / 96;
    const int part = cq >> 5, within = (cq & 31) * 4;
    const int wcol = part * 1024 + h * 128 + within;
    float w[4][4];
#pragma unroll
    for (int k = 0; k < 4; ++k)
#pragma unroll
      for (int c = 0; c < 4; ++c) w[k][c] = p.dn_conv_w[k * 3072 + wcol + c];
    float win[3][4];
    const int pos0 = n * 64 + tg * 16;
#pragma unroll
    for (int i = 0; i < 3; ++i) {
      const int pos = pos0 - 3 + i;
      if (pos >= 0) { const u32x2 r = *(const u32x2*)(proj + ((size_t)b * SEQ + pos) * PROJ_N + 3072 + wcol); win[i][0] = bflo(r.x); win[i][1] = bfhi(r.x); win[i][2] = bflo(r.y); win[i][3] = bfhi(r.y); }
      else { win[i][0] = win[i][1] = win[i][2] = win[i][3] = 0.f; }
    }
    float* dstbase = (part == 0 ? qs : part == 1 ? ks : vs) + within;
#pragma unroll
    for (int i = 0; i < 16; ++i) {
      const u32x2 r = *(const u32x2*)(proj + ((size_t)b * SEQ + pos0 + i) * PROJ_N + 3072 + wcol);
      float cur[4] = {bflo(r.x), bfhi(r.x), bflo(r.y), bfhi(r.y)};
      f32x4 o;
#pragma unroll
      for (int c = 0; c < 4; ++c) { const float a = w[0][c] * win[0][c] + w[1][c] * win[1][c] + w[2][c] * win[2][c] + w[3][c] * cur[c]; o[c] = siluf_(a); win[0][c] = win[1][c]; win[1][c] = win[2][c]; win[2][c] = cur[c]; }
      *(f32x4*)(dstbase + (tg * 16 + i) * QS_LD) = o;
    }
  } else if (wave == 7) {
    const float bl = ext[(tok0 + lane) * 16 + h], al = ext[(tok0 + lane) * 16 + 8 + h];
    float g = -__expf(p.dn_a_log[h]) * softplusf_(al + p.dn_dt_bias[h]);
#pragma unroll
    for (int o = 1; o < 64; o <<= 1) { const float t = __shfl_up(g, o); if (lane >= o) g += t; }
    gcs[lane] = g; betas[lane] = sigmoidf_(bl);
    if (lane == 63) GL[chunk] = g;
  }
  __syncthreads();
  {
    const int row = tid >> 2, part = tid & 3;
    float* base = (row < 64 ? qs + row * QS_LD : ks + (row - 64) * QS_LD) + part * 32;
    f32x4 v[8]; float ss = 0.f;
#pragma unroll
    for (int i = 0; i < 8; ++i) { v[i] = *(const f32x4*)(base + 4 * i); ss += v[i][0] * v[i][0] + v[i][1] * v[i][1] + v[i][2] * v[i][2] + v[i][3] * v[i][3]; }
    ss += __shfl_xor(ss, 1); ss += __shfl_xor(ss, 2);
    float rs = rsqrtf(ss + EPS); if (row < 64) rs *= 0.08838834764831845f;
#pragma unroll
    for (int i = 0; i < 8; ++i) *(f32x4*)(base + 4 * i) = v[i] * rs;
  }
  __syncthreads();
  {
    const int sel = wave >> 2, mb = wave & 3, r = lane & 15, quad = lane >> 4;
    const float* X = sel ? qs : ks;
    bf16x8 af[4];
#pragma unroll
    for (int kk = 0; kk < 4; ++kk) {
      const f32x4 a0 = *(const f32x4*)(X + (16 * mb + r) * QS_LD + 32 * kk + 8 * quad), a1 = *(const f32x4*)(X + (16 * mb + r) * QS_LD + 32 * kk + 8 * quad + 4);
      u32x4 t; t[0] = pk_bf16(a0[0], a0[1]); t[1] = pk_bf16(a0[2], a0[3]); t[2] = pk_bf16(a1[0], a1[1]); t[3] = pk_bf16(a1[2], a1[3]);
      af[kk] = __builtin_bit_cast(bf16x8, t);
    }
    for (int nb = 0; nb < 4; ++nb) {
      f32x4 d = {0.f, 0.f, 0.f, 0.f};
      if (nb <= mb) {
#pragma unroll
        for (int kk = 0; kk < 4; ++kk) {
          const f32x4 b0 = *(const f32x4*)(ks + (16 * nb + r) * QS_LD + 32 * kk + 8 * quad), b1 = *(const f32x4*)(ks + (16 * nb + r) * QS_LD + 32 * kk + 8 * quad + 4);
          u32x4 t; t[0] = pk_bf16(b0[0], b0[1]); t[1] = pk_bf16(b0[2], b0[3]); t[2] = pk_bf16(b1[0], b1[1]); t[3] = pk_bf16(b1[2], b1[3]);
          d = __builtin_amdgcn_mfma_f32_16x16x32_bf16(af[kk], __builtin_bit_cast(bf16x8, t), d, 0, 0, 0);
        }
      }
      const int j = 16 * nb + r; const float gj = gcs[j];
#pragma unroll
      for (int reg = 0; reg < 4; ++reg) {
        const int i = 16 * mb + 4 * quad + reg;
        float val = 0.f;
        if (sel == 0) { if (j < i) val = d[reg] * __expf(gcs[i] - gj) * betas[i]; Lm[j * LM_LD + i] = val; }
        else { if (j <= i) val = d[reg] * __expf(gcs[i] - gj); QAg[(size_t)chunk * 4096 + i * 64 + permcol(j)] = (bf16_t)(pk_bf16(val, 0.f) & 0xffff); }
      }
    }
    { const int row = tid >> 3, c0 = (tid & 7) * 16; const float e = __expf(gcs[row]);
#pragma unroll
      for (int i = 0; i < 4; ++i) { const f32x4 v = *(const f32x4*)(qs + row * QS_LD + c0 + 4 * i) * e; u32x2 o; o.x = pk_bf16(v[0], v[1]); o.y = pk_bf16(v[2], v[3]);
        *(u32x2*)(QDg + (size_t)chunk * 8192 + row * 128 + permcol(c0 + 4 * i)) = o; } }
    { const int d = tid >> 2, t0 = (tid & 3) * 16; const float gl = gcs[63];
#pragma unroll
      for (int i = 0; i < 4; ++i) { float a[4];
#pragma unroll
        for (int e = 0; e < 4; ++e) a[e] = ks[(t0 + 4 * i + e) * QS_LD + d] * __expf(gl - gcs[t0 + 4 * i + e]);
        u32x2 o; o.x = pk_bf16(a[0], a[1]); o.y = pk_bf16(a[2], a[3]);
        *(u32x2*)(KTg + (size_t)chunk * 8192 + d * 64 + permcol(t0 + 4 * i)) = o; } }
  }
  __syncthreads();
  }
  if (tid < 256) {
    const int c = tid & 127; const bool isw = tid >= 128;
    float* src = (isw ? ks : vs) + c;
    bf16_t* dst = isw ? Wg + (size_t)chunk * 8192 + permcol(c) : Ug + (size_t)chunk * 8192 + c * 64;
#pragma unroll 1
    for (int ib = 0; ib < 4; ++ib) {
      float rr[16];
#pragma unroll
      for (int ii = 0; ii < 16; ++ii) { const int i = 16 * ib + ii; float v = src[i * QS_LD] * betas[i]; if (isw) v *= __expf(gcs[i]); rr[ii] = v; }
#pragma unroll 2
      for (int j = 0; j < 16 * ib; ++j) {
        const float xj = src[j * QS_LD];
        const f32x4* lp = (const f32x4*)(Lm + j * LM_LD + 16 * ib);
#pragma unroll
        for (int q = 0; q < 4; ++q) { const f32x4 l = lp[q];
#pragma unroll
          for (int e = 0; e < 4; ++e) rr[4 * q + e] -= l[e] * xj; }
      }
#pragma unroll
      for (int jj = 0; jj < 16; ++jj) {
        const float xj = rr[jj];
        src[(16 * ib + jj) * QS_LD] = xj;
        if (isw) dst[(16 * ib + jj) * 128] = (bf16_t)(pk_bf16(xj, 0.f) & 0xffff);
        else if ((jj & 3) == 3) { u32x2 o; o.x = pk_bf16(rr[jj - 3], rr[jj - 2]); o.y = pk_bf16(rr[jj - 1], xj); *(u32x2*)(dst + 16 * ib + jj - 3) = o; }
        const f32x4* lp = (const f32x4*)(Lm + (16 * ib + jj) * LM_LD + 16 * ib);
#pragma unroll
        for (int q = (jj + 1) / 4; q < 4; ++q) { const f32x4 l = lp[q];
#pragma unroll
          for (int e = 0; e < 4; ++e) if (4 * q + e > jj) rr[4 * q + e] -= l[e] * xj; }
      }
    }
  }
  __syncthreads();
}

typedef short s16x4 __attribute__((ext_vector_type(4)));
constexpr int WL_BYTES = 20480, TL_LD = 68;
DI int img_off(int row, int c32) { return row * 256 + ((c32 ^ (row & 7)) << 5); }
DI s16x4 tr_read1(unsigned a0);
DI bf16x8 tr_read2(unsigned a0, unsigned a1) {
  const s16x4 lo = tr_read1(a0), hi = tr_read1(a1);
  return __builtin_shufflevector(lo, hi, 0, 1, 2, 3, 4, 5, 6, 7);
}
DI void tr_read4(unsigned a0, unsigned a1, unsigned a2, unsigned a3, s16x4& r0, s16x4& r1, s16x4& r2, s16x4& r3) {
  asm volatile("ds_read_b64_tr_b16 %0, %4\n\tds_read_b64_tr_b16 %1, %5\n\tds_read_b64_tr_b16 %2, %6\n\tds_read_b64_tr_b16 %3, %7\n\ts_waitcnt lgkmcnt(0)"
               : "=&v"(r0), "=&v"(r1), "=&v"(r2), "=&v"(r3) : "v"(a0), "v"(a1), "v"(a2), "v"(a3) : "memory");
}
DI s16x4 tr_read1(unsigned a0) { s16x4 lo; asm volatile("ds_read_b64_tr_b16 %0, %1\n\ts_waitcnt lgkmcnt(0)" : "=&v"(lo) : "v"(a0) : "memory"); return lo; }
#ifndef DBG_NOSOLVE
#define DBG_NOSOLVE 0
#endif
#ifndef DNW_OUT
#define DNW_OUT 63
#endif
DI void dn_chunk_wave(const Params& p, int chunk_, char* smem_) {
  const int TIDX = launder_tid();
  const int chunk = __builtin_amdgcn_readfirstlane(chunk_);
  char* wl = smem_ + __builtin_amdgcn_readfirstlane(TIDX >> 6) * WL_BYTES;
  char* ws = p.ws;
  const bf16_t* proj = (const bf16_t*)(ws + OFF_PROJ);
  const float* ext = (const float*)(ws + OFF_EXT);
  bf16_t* Ug = (bf16_t*)p.out;
  bf16_t* Wg = Ug + (size_t)NCHUNK * 8192; bf16_t* QDg = Wg + (size_t)NCHUNK * 8192; bf16_t* KTg = QDg + (size_t)NCHUNK * 8192;
  bf16_t* QAg = (bf16_t*)(ws + OFF_QA);
  float* GL = (float*)(ws + OFF_GL);
  float* T = (float*)wl;
  const unsigned wl_addr = (unsigned)(size_t)wl;
  int lane = TIDX & 63;
#define r (lane & 15)
#define quad (lane >> 4)
#define RELAUNDER() asm volatile("" : "+v"(lane))
  const int bh = chunk >> 6, n = chunk & 63, b = bh >> 3, h = bh & 7;
  const size_t tok0 = (size_t)b * SEQ + n * 64;
  float gcl, betal;
  {
    const float bl = ext[(tok0 + lane) * 16 + h], al = ext[(tok0 + lane) * 16 + 8 + h];
    float g = -__expf(p.dn_a_log[h]) * softplusf_(al + p.dn_dt_bias[h]);
#pragma unroll
    for (int o = 1; o < 64; o <<= 1) { const float t = __shfl_up(g, o); if (lane >= o) g += t; }
    gcl = g; betal = sigmoidf_(bl);
    if ((DNW_OUT & 32) && lane == 63) GL[chunk] = g;
  }
  auto load_w = [&](int part, int kk, f32x4 (&wt)[4][2]) {
    const int col = part * 1024 + h * 128 + 32 * kk + 8 * quad;
#pragma unroll
    for (int tap = 0; tap < 4; ++tap) { const unsigned o = (unsigned)(tap * 3072 + col) * 4u; wt[tap][0] = *(const f32x4*)((const char*)p.dn_conv_w + o); wt[tap][1] = *(const f32x4*)((const char*)p.dn_conv_w + o + 16u); }
  };
  auto conv_frag = [&](int part, int mb, int kk, const f32x4 (&wt)[4][2], float (&out)[8]) {
    const int col = part * 1024 + h * 128 + 32 * kk + 8 * quad;
    float a[8];
#pragma unroll
    for (int c = 0; c < 8; ++c) a[c] = 0.f;
#pragma unroll
    for (int tap = 0; tap < 4; ++tap) {
      const int pos = n * 64 + 16 * mb + r - 3 + tap;
      u32x4 raw = {0u, 0u, 0u, 0u};
      if (pos >= 0) raw = *(const u32x4*)((const char*)proj + ((unsigned)(b * SEQ + pos) * (unsigned)PROJ_N + 3072u + (unsigned)col) * 2u);
      a[0] += wt[tap][0][0] * bflo(raw[0]); a[1] += wt[tap][0][1] * bfhi(raw[0]); a[2] += wt[tap][0][2] * bflo(raw[1]); a[3] += wt[tap][0][3] * bfhi(raw[1]);
      a[4] += wt[tap][1][0] * bflo(raw[2]); a[5] += wt[tap][1][1] * bfhi(raw[2]); a[6] += wt[tap][1][2] * bflo(raw[3]); a[7] += wt[tap][1][3] * bfhi(raw[3]);
    }
#pragma unroll
    for (int c = 0; c < 8; ++c) out[c] = siluf_(a[c]);
  };
  auto pack8 = [&](const float (&v)[8], float sc) -> bf16x8 {
    u32x4 t; t[0] = pk_bf16(v[0] * sc, v[1] * sc); t[1] = pk_bf16(v[2] * sc, v[3] * sc); t[2] = pk_bf16(v[4] * sc, v[5] * sc); t[3] = pk_bf16(v[6] * sc, v[7] * sc);
    return __builtin_bit_cast(bf16x8, t);
  };
  auto scale8 = [&](bf16x8 f, float sc) -> u32x4 {
    const u32x4 t = __builtin_bit_cast(u32x4, f); u32x4 o;
#pragma unroll
    for (int i = 0; i < 4; ++i) o[i] = pk_bf16(bflo(t[i]) * sc, bfhi(t[i]) * sc);
    return o;
  };
  bf16x8 kfrag[4][4];
  float rskl;
  {
    float ss[4] = {0.f, 0.f, 0.f, 0.f};
#pragma unroll
    for (int kk = 0; kk < 4; ++kk) {
      f32x4 wt[4][2]; load_w(1, kk, wt);
#pragma unroll
      for (int mb = 0; mb < 4; ++mb) { float f[8]; conv_frag(1, mb, kk, wt, f); kfrag[mb][kk] = pack8(f, 1.f);
#pragma unroll
        for (int c = 0; c < 8; ++c) ss[mb] += f[c] * f[c];
        if (mb == 3) { asm volatile("" ::: "memory"); __builtin_amdgcn_sched_barrier(0); } }
    }
#pragma unroll
    for (int mb = 0; mb < 4; ++mb) { float t = ss[mb]; t += __shfl_xor(t, 16); t += __shfl_xor(t, 32); ss[mb] = rsqrtf(t + EPS); }
    rskl = quad == 0 ? ss[0] : quad == 1 ? ss[1] : quad == 2 ? ss[2] : ss[3];
  }
#ifndef DNW_STOP
#define DNW_STOP 99
#endif
  if (DNW_STOP == 1) { if (kfrag[0][0][0] == 12345 && kfrag[3][3][1] == 7 && kfrag[1][2][3] == 5 && kfrag[2][1][0] == 9) GL[0] = 1.f; return; }
  RELAUNDER();
  const float glast = __shfl(gcl, 63);
  float gcr[4], betar[4], rskr[4];
#pragma unroll
  for (int mb = 0; mb < 4; ++mb) { gcr[mb] = __shfl(gcl, 16 * mb + r); betar[mb] = __shfl(betal, 16 * mb + r); rskr[mb] = __shfl(rskl, 16 * mb + r); }
#pragma unroll
  for (int mb = 0; mb < 4; ++mb) {
    float gci[4], bi[4];
#pragma unroll
    for (int reg = 0; reg < 4; ++reg) { gci[reg] = __shfl(gcl, 16 * mb + 4 * quad + reg); bi[reg] = __shfl(betal, 16 * mb + 4 * quad + reg) * __shfl(rskl, 16 * mb + 4 * quad + reg); }
#pragma unroll
    for (int nb = 0; nb < 4; ++nb) {
      f32x4 dl = {0.f, 0.f, 0.f, 0.f};
      if (nb <= mb) {
#pragma unroll
        for (int kk = 0; kk < 4; ++kk) dl = __builtin_amdgcn_mfma_f32_16x16x32_bf16(kfrag[mb][kk], kfrag[nb][kk], dl, 0, 0, 0);
      }
      const int j = 16 * nb + r; const float gj = gcr[nb], rj = rskr[nb];
      f32x4 lv;
#pragma unroll
      for (int reg = 0; reg < 4; ++reg) { const int i = 16 * mb + 4 * quad + reg; lv[reg] = (nb <= mb && j < i) ? dl[reg] * __expf(fminf(gci[reg] - gj, 0.f)) * (bi[reg] * rj) : 0.f; }
      *(f32x4*)(T + j * TL_LD + 16 * mb + 4 * quad) = lv;
      __builtin_amdgcn_sched_barrier(0);
    }
  }
  RELAUNDER();
#pragma unroll 1
  for (int mb = 0; mb < 4; ++mb) {
    bf16x8 qf[4];
    float rsq;
    {
      float ss = 0.f;
#pragma unroll
      for (int kk = 0; kk < 4; ++kk) { f32x4 wt[4][2]; load_w(0, kk, wt); float f[8]; conv_frag(0, mb, kk, wt, f); qf[kk] = pack8(f, 1.f);
#pragma unroll
        for (int c = 0; c < 8; ++c) ss += f[c] * f[c];
        if (kk == 3) { asm volatile("" ::: "memory"); __builtin_amdgcn_sched_barrier(0); } }
      ss += __shfl_xor(ss, 16); ss += __shfl_xor(ss, 32);
      rsq = rsqrtf(ss + EPS) * 0.08838834764831845f;
    }
    {
      const float sq = __expf(__shfl(gcl, 16 * mb + r)) * rsq;
      bf16_t* dq = QDg + (size_t)chunk * 8192 + (16 * mb + r) * 128;
#pragma unroll
      for (int kk = 0; kk < 4; ++kk) { const u32x4 qd = scale8(qf[kk], sq);
        if (DNW_OUT & 4) { *(u32x2*)(dq + permcol(32 * kk + 8 * quad)) = (u32x2){qd[0], qd[1]}; *(u32x2*)(dq + permcol(32 * kk + 8 * quad + 4)) = (u32x2){qd[2], qd[3]}; } }
    }
    float gci[4], rqi[4];
#pragma unroll
    for (int reg = 0; reg < 4; ++reg) { gci[reg] = __shfl(gcl, 16 * mb + 4 * quad + reg); rqi[reg] = __shfl(rsq, 4 * quad + reg); }
    bf16_t* qrow = QAg + (size_t)chunk * 4096 + (16 * mb + 4 * quad) * 64;
#pragma unroll
    for (int nb = 0; nb < 4; ++nb) {
      f32x4 dq = {0.f, 0.f, 0.f, 0.f};
#pragma unroll
      for (int kk = 0; kk < 4; ++kk) dq = __builtin_amdgcn_mfma_f32_16x16x32_bf16(qf[kk], kfrag[nb][kk], dq, 0, 0, 0);
      const int j = 16 * nb + r; const float gj = gcr[nb], rj = rskr[nb];
#pragma unroll
      for (int reg = 0; reg < 4; ++reg) {
        const int i = 16 * mb + 4 * quad + reg;
        const float qv = (j <= i) ? dq[reg] * __expf(fminf(gci[reg] - gj, 0.f)) * (rqi[reg] * rj) : 0.f;
        if (DNW_OUT & 16) qrow[reg * 64 + permcol(j)] = (bf16_t)(pk_bf16(qv, 0.f) & 0xffff);
      }
    }
  }
  wave_lds_sync();
  if (DNW_STOP == 2) { if (kfrag[0][0][0] == 12345) GL[0] = 1.f; return; }
  RELAUNDER();
  {
    const int c = lane;
#pragma unroll 1
    for (int ib = 0; ib < (DBG_NOSOLVE ? 0 : 4); ++ib) {
      float rr[16];
#pragma unroll
      for (int ii = 0; ii < 16; ++ii) rr[ii] = (16 * ib + ii == c) ? 1.f : 0.f;
#pragma unroll 2
      for (int j = 0; j < 16 * ib; ++j) {
        const float xj = T[c * TL_LD + j];
        const f32x4* lp = (const f32x4*)(T + j * TL_LD + 16 * ib);
#pragma unroll
        for (int q = 0; q < 4; ++q) { const f32x4 l = lp[q];
#pragma unroll
          for (int e = 0; e < 4; ++e) rr[4 * q + e] -= l[e] * xj; }
      }
#pragma unroll
      for (int jj = 0; jj < 16; ++jj) {
        const float xj = rr[jj];
        const f32x4* lp = (const f32x4*)(T + (16 * ib + jj) * TL_LD + 16 * ib);
#pragma unroll
        for (int q = (jj + 1) / 4; q < 4; ++q) { const f32x4 l = lp[q];
#pragma unroll
          for (int e = 0; e < 4; ++e) if (4 * q + e > jj) rr[4 * q + e] -= l[e] * xj; }
      }
      wave_lds_sync();
#pragma unroll
      for (int q = 0; q < 4; ++q) *(f32x4*)(T + c * TL_LD + 16 * ib + 4 * q) = (f32x4){rr[4 * q], rr[4 * q + 1], rr[4 * q + 2], rr[4 * q + 3]};
      wave_lds_sync();
    }
  }
  if (DNW_STOP == 3) { if (kfrag[0][0][0] == 12345) GL[0] = 1.f; return; }
  RELAUNDER();
  bf16x8 tfrag[4][2];
#pragma unroll
  for (int mb = 0; mb < 4; ++mb)
#pragma unroll
    for (int k2 = 0; k2 < 2; ++k2) {
      float v[8];
#pragma unroll
      for (int jj = 0; jj < 8; ++jj) v[jj] = T[(32 * k2 + 8 * quad + jj) * TL_LD + 16 * mb + r];
      tfrag[mb][k2] = pack8(v, 1.f);
      __builtin_amdgcn_sched_barrier(0);
    }
  wave_lds_sync();
#define i16q ((lane & 15) >> 2)
#define i16p (lane & 3)
  RELAUNDER();
#pragma unroll 1
  for (int kk = 0; kk < 4; ++kk) {
    f32x4 wt[4][2]; load_w(2, kk, wt);
#pragma unroll 4
    for (int mb = 0; mb < 4; ++mb) { float f[8]; conv_frag(2, mb, kk, wt, f);
      *(bf16x8*)(wl + img_off(16 * mb + r, 2 * kk + (quad >> 1)) + 16 * (quad & 1)) = pack8(f, __shfl(betal, 16 * mb + r)); }
  }
  wave_lds_sync();
#pragma unroll 1
  for (int cb = 0; cb < 8; ++cb) {
    bf16x8 bf[2];
    { const int t0 = 8 * quad + i16q; s16x4 x0, x1, x2, x3;
      tr_read4(wl_addr + img_off(t0, cb) + 8 * i16p, wl_addr + img_off(t0 + 4, cb) + 8 * i16p, wl_addr + img_off(t0 + 32, cb) + 8 * i16p, wl_addr + img_off(t0 + 36, cb) + 8 * i16p, x0, x1, x2, x3);
      bf[0] = __builtin_shufflevector(x0, x1, 0, 1, 2, 3, 4, 5, 6, 7); bf[1] = __builtin_shufflevector(x2, x3, 0, 1, 2, 3, 4, 5, 6, 7); }
#pragma unroll
    for (int mb = 0; mb < 4; ++mb) {
      f32x4 d = {0.f, 0.f, 0.f, 0.f};
#pragma unroll
      for (int k2 = 0; k2 < 2; ++k2) d = __builtin_amdgcn_mfma_f32_16x16x32_bf16(tfrag[mb][k2], bf[k2], d, 0, 0, 0);
      u32x2 o; o.x = pk_bf16_mfma(d[0], d[1]); o.y = pk_bf16_mfma(d[2], d[3]);
      if (DNW_OUT & 1) *(u32x2*)(Ug + (size_t)chunk * 8192 + (16 * cb + r) * 64 + 16 * mb + 4 * quad) = o;
    }
  }
  wave_lds_sync();
  if (DNW_STOP == 4) { if (kfrag[0][0][0] == 12345) GL[0] = 1.f; return; }
  RELAUNDER();
#pragma unroll
  for (int mb = 0; mb < 4; ++mb) { const float sc = betar[mb] * __expf(gcr[mb]) * rskr[mb];
#pragma unroll
    for (int kk = 0; kk < 4; ++kk) *(u32x4*)(wl + img_off(16 * mb + r, 2 * kk + (quad >> 1)) + 16 * (quad & 1)) = scale8(kfrag[mb][kk], sc);
    __builtin_amdgcn_sched_barrier(0); }
  wave_lds_sync();
#pragma unroll 1
  for (int cb = 0; cb < 8; ++cb) {
    bf16x8 af[2];
    { const int t0 = 8 * quad + i16q; s16x4 x0, x1, x2, x3;
      tr_read4(wl_addr + img_off(t0, cb) + 8 * i16p, wl_addr + img_off(t0 + 4, cb) + 8 * i16p, wl_addr + img_off(t0 + 32, cb) + 8 * i16p, wl_addr + img_off(t0 + 36, cb) + 8 * i16p, x0, x1, x2, x3);
      af[0] = __builtin_shufflevector(x0, x1, 0, 1, 2, 3, 4, 5, 6, 7); af[1] = __builtin_shufflevector(x2, x3, 0, 1, 2, 3, 4, 5, 6, 7); }
#pragma unroll
    for (int mb = 0; mb < 4; ++mb) {
      f32x4 d = {0.f, 0.f, 0.f, 0.f};
#pragma unroll
      for (int k2 = 0; k2 < 2; ++k2) d = __builtin_amdgcn_mfma_f32_16x16x32_bf16(af[k2], tfrag[mb][k2], d, 0, 0, 0);
      u32x2 o; o.x = pk_bf16_mfma(d[0], d[1]); o.y = pk_bf16_mfma(d[2], d[3]);
      if (DNW_OUT & 2) *(u32x2*)(Wg + (size_t)chunk * 8192 + (16 * mb + r) * 128 + permcol(16 * cb + 4 * quad)) = o;
    }
  }
  wave_lds_sync();
  RELAUNDER();
#pragma unroll
  for (int mb = 0; mb < 4; ++mb) { const float sk = __expf(glast - gcr[mb]) * rskr[mb];
#pragma unroll
    for (int kk = 0; kk < 4; ++kk) *(u32x4*)(wl + img_off(16 * mb + r, 2 * kk + (quad >> 1)) + 16 * (quad & 1)) = scale8(kfrag[mb][kk], sk);
    __builtin_amdgcn_sched_barrier(0); }
  wave_lds_sync();
#pragma unroll 1
  for (int cb = 0; cb < 8; ++cb)
    {
      s16x4 v0, v1, v2, v3; const int t0 = 4 * quad + i16q;
      tr_read4(wl_addr + img_off(t0, cb) + 8 * i16p, wl_addr + img_off(t0 + 16, cb) + 8 * i16p, wl_addr + img_off(t0 + 32, cb) + 8 * i16p, wl_addr + img_off(t0 + 48, cb) + 8 * i16p, v0, v1, v2, v3);
      bf16_t* kt = KTg + (size_t)chunk * 8192 + (16 * cb + r) * 64;
      if (DNW_OUT & 8) { *(s16x4*)(kt + permcol(4 * quad)) = v0; *(s16x4*)(kt + permcol(16 + 4 * quad)) = v1; *(s16x4*)(kt + permcol(32 + 4 * quad)) = v2; *(s16x4*)(kt + permcol(48 + 4 * quad)) = v3; }
    }
  wave_lds_sync();
}
#undef r
#undef quad
#undef RELAUNDER
#undef i16q
#undef i16p

constexpr int VS_LD = 136;
DI void sb_unit(const Params& p, int unit, bf16_t* vl) {
  const int TIDX = launder_tid();
  char* ws = p.ws;
  const bf16_t* proj = (const bf16_t*)(ws + OFF_PROJ);
  bf16_t* mix = (bf16_t*)(ws + OFF_A);
  const int lane = TIDX & 63, r = lane & 31, hh = lane >> 5;
  const int b = unit >> 10, h = (unit >> 7) & 7, qb = unit & 127;
  const size_t rowbase = (size_t)b * SEQ;
  const int t0 = qb * 32;
  bf16x8 qf[8];
#pragma unroll
  for (int kk = 0; kk < 8; ++kk) qf[kk] = *(const bf16x8*)(proj + (rowbase + t0 + r) * PROJ_N + h * 128 + 16 * kk + 8 * hh);
  bf16x8 uf[2];
#pragma unroll
  for (int st = 0; st < 2; ++st)
#pragma unroll
    for (int j = 0; j < 8; ++j) { const int key = 16 * st + 8 * (j >> 2) + 4 * hh + (j & 3); uf[st][j] = (short)(key >= r ? 0x3F80 : 0); }
  float carry = 0.f;
  f32x16 o[4];
#pragma unroll
  for (int db = 0; db < 4; ++db)
#pragma unroll
    for (int i = 0; i < 16; ++i) o[db][i] = 0.f;
  const float scale = 0.08838834764831845f;
  for (int kb = qb; kb >= 0; --kb) {
    const int s0 = kb * 32;
#pragma unroll
    for (int i = 0; i < 8; ++i) { const int idx = lane + 64 * i, key = idx >> 4, c16 = idx & 15;
      *(u32x4*)(vl + key * VS_LD + c16 * 8) = *(const u32x4*)(proj + (rowbase + s0 + key) * PROJ_N + 2048 + h * 128 + c16 * 8); }
    f32x16 z;
#pragma unroll
    for (int i = 0; i < 16; ++i) z[i] = 0.f;
#pragma unroll
    for (int kk = 0; kk < 8; ++kk) {
      const bf16x8 kf = *(const bf16x8*)(proj + (rowbase + s0 + r) * PROJ_N + 1024 + h * 128 + 16 * kk + 8 * hh);
      z = __builtin_amdgcn_mfma_f32_32x32x16_bf16(kf, qf[kk], z, 0, 0, 0);
    }
    float sp[16]; bool valid[16];
#pragma unroll
    for (int i = 0; i < 16; ++i) {
      const int key = (i & 3) + 8 * (i >> 2) + 4 * hh;
      z[i] *= scale;
      valid[i] = (kb < qb) || (key < r);
      sp[i] = valid[i] ? softplusf_(z[i]) : 0.f;
    }
    f32x16 ct;
#pragma unroll
    for (int i = 0; i < 16; ++i) ct[i] = carry;
#pragma unroll
    for (int st = 0; st < 2; ++st) {
      u32x4 hi, lo;
#pragma unroll
      for (int j2 = 0; j2 < 4; ++j2) {
        const float a = sp[8 * st + 2 * j2], c = sp[8 * st + 2 * j2 + 1];
        const unsigned hp = pk_bf16(a, c);
        hi[j2] = hp; lo[j2] = pk_bf16(a - bflo(hp), c - bfhi(hp));
      }
      ct = __builtin_amdgcn_mfma_f32_32x32x16_bf16(uf[st], __builtin_bit_cast(bf16x8, hi), ct, 0, 0, 0);
      ct = __builtin_amdgcn_mfma_f32_32x32x16_bf16(uf[st], __builtin_bit_cast(bf16x8, lo), ct, 0, 0, 0);
    }
    bf16x8 pa[2];
#pragma unroll
    for (int st = 0; st < 2; ++st) {
      u32x4 t;
#pragma unroll
      for (int j2 = 0; j2 < 4; ++j2) {
        const int i0 = 8 * st + 2 * j2;
        const float a = valid[i0] ? __expf(z[i0] - ct[i0]) : 0.f, c = valid[i0 + 1] ? __expf(z[i0 + 1] - ct[i0 + 1]) : 0.f;
        t[j2] = pk_bf16(a, c);
      }
      pa[st] = __builtin_bit_cast(bf16x8, t);
    }
    carry = __shfl(ct[0], r);
    wave_lds_sync();
#pragma unroll
    for (int db = 0; db < 4; ++db)
#pragma unroll
      for (int st = 0; st < 2; ++st) {
        bf16x8 vf;
#pragma unroll
        for (int j = 0; j < 8; ++j) { const int key = 16 * st + 8 * (j >> 2) + 4 * hh + (j & 3); vf[j] = (short)vl[key * VS_LD + 32 * db + r]; }
        o[db] = __builtin_amdgcn_mfma_f32_32x32x16_bf16(vf, pa[st], o[db], 0, 0, 0);
      }
    wave_lds_sync();
    if (__all(carry > 104.f)) break;
  }
  float ss = 0.f;
#pragma unroll
  for (int db = 0; db < 4; ++db)
#pragma unroll
    for (int i = 0; i < 16; ++i) ss += o[db][i] * o[db][i];
  ss += __shfl_xor(ss, 32);
  const float rs = rsqrtf(ss * (1.f / 128.f) + EPS);
#pragma unroll
  for (int db = 0; db < 4; ++db)
#pragma unroll
    for (int g4 = 0; g4 < 4; ++g4) {
      const int d = 32 * db + 8 * g4 + 4 * hh;
      const f32x4 gn = *(const f32x4*)(p.sb_gain + d);
      u32x2 v; v.x = pk_bf16(o[db][4 * g4] * rs * gn[0], o[db][4 * g4 + 1] * rs * gn[1]); v.y = pk_bf16(o[db][4 * g4 + 2] * rs * gn[2], o[db][4 * g4 + 3] * rs * gn[3]);
      *(u32x2*)(vl + r * VS_LD + d) = v;
    }
  wave_lds_sync();
#pragma unroll
  for (int i = 0; i < 8; ++i) { const int idx = lane + 64 * i, q = idx >> 4, c16 = idx & 15;
    *(u32x4*)(mix + (rowbase + t0 + q) * D_MODEL + h * 128 + c16 * 8) = *(const u32x4*)(vl + q * VS_LD + c16 * 8); }
  wave_lds_sync();
}

DI bf16x8 pack_rows(const f32x4& a, const f32x4& b) { u32x4 t; t[0] = pk_bf16_mfma(a[0], a[1]); t[1] = pk_bf16_mfma(a[2], a[3]); t[2] = pk_bf16_mfma(b[0], b[1]); t[3] = pk_bf16_mfma(b[2], b[3]); return __builtin_bit_cast(bf16x8, t); }
constexpr int SC_W = 0, SC_QD = 16384, SC_KT = 32768, SC_QA = 49152, SC_U = 57344, SC_BUF = 65536;
DI int swz256(int row, int ch) { return row * 256 + ((ch ^ (row & 15)) << 4); }
DI int swz128(int row, int ch) { return row * 128 + ((ch ^ ((row >> 1) & 7)) << 4); }
DI void dn_scan_block(const Params& p, int unit, char* smem) {
  const int TIDX = launder_tid();
  char* ws = p.ws;
  const bf16_t* Ug = (const bf16_t*)p.out;
  const bf16_t* Wg = Ug + (size_t)NCHUNK * 8192; const bf16_t* QDg = Wg + (size_t)NCHUNK * 8192; const bf16_t* KTg = QDg + (size_t)NCHUNK * 8192;
  const bf16_t* QAg = (const bf16_t*)(ws + OFF_QA);
  const float* GL = (const float*)(ws + OFF_GL);
  float* odn = (float*)(ws + OFF_ODN);
  const int bh = unit >> 1, half = unit & 1, b = bh >> 3, h = bh & 7;
  const int wave = TIDX >> 6, lane = TIDX & 63, r = lane & 15, quad = lane >> 4;
  const int e0 = half * 64 + wave * 16;
  const int lt = TIDX & 255;
#define SC_OFF(i) ((i) < 4 ? SC_W + swz256((lt + 256 * (i)) >> 4, (lt + 256 * (i)) & 15) : (i) < 8 ? SC_QD + swz256((lt + 256 * ((i) - 4)) >> 4, (lt + 256 * ((i) - 4)) & 15) : \
                    (i) < 12 ? SC_KT + swz128((lt + 256 * ((i) - 8)) >> 3, (lt + 256 * ((i) - 8)) & 7) : (i) < 14 ? SC_QA + swz128((lt + 256 * ((i) - 12)) >> 3, (lt + 256 * ((i) - 12)) & 7) : \
                    SC_U + swz128((lt + 256 * ((i) - 14)) >> 3, (lt + 256 * ((i) - 14)) & 7))
#define SC_SRC(i, c_) ((i) < 4 ? Wg + (c_) * 8192 + (lt + 256 * (i)) * 8 : (i) < 8 ? QDg + (c_) * 8192 + (lt + 256 * ((i) - 4)) * 8 : (i) < 12 ? KTg + (c_) * 8192 + (lt + 256 * ((i) - 8)) * 8 : \
                       (i) < 14 ? QAg + (c_) * 4096 + (lt + 256 * ((i) - 12)) * 8 : Ug + (c_) * 8192 + half * 4096 + (lt + 256 * ((i) - 14)) * 8)
#define SC_LOAD(st, chunk) do { const size_t c_ = (chunk); _Pragma("unroll") for (int i_ = 0; i_ < 16; ++i_) st[i_] = *(const u32x4*)(SC_SRC(i_, c_)); } while (0)
#define SC_STORE(st, buf) do { char* b_ = smem + (buf) * SC_BUF; _Pragma("unroll") for (int i_ = 0; i_ < 16; ++i_) *(u32x4*)(b_ + SC_OFF(i_)) = st[i_]; } while (0)
  f32x4 S[8];
#pragma unroll
  for (int i = 0; i < 8; ++i) S[i] = (f32x4){0.f, 0.f, 0.f, 0.f};
  const size_t chunk0 = (size_t)bh * 64;
  const float eglv = __expf(GL[chunk0 + lane]);
  auto compute = [&](int n) {
    if (wave < 4) {
      const char* B = smem + (n & 1) * SC_BUF;
      bf16x8 Sb[4];
#pragma unroll
      for (int kk = 0; kk < 4; ++kk) Sb[kk] = pack_rows(S[2 * kk], S[2 * kk + 1]);
      f32x4 vn[4];
#pragma unroll
      for (int tb = 0; tb < 4; ++tb) {
        f32x4 acc = {0.f, 0.f, 0.f, 0.f};
#pragma unroll
        for (int kk = 0; kk < 4; ++kk) acc = __builtin_amdgcn_mfma_f32_16x16x32_bf16(*(const bf16x8*)(B + SC_W + swz256(16 * tb + r, 4 * kk + quad)), Sb[kk], acc, 0, 0, 0);
        const u32x2 uu = *(const u32x2*)(B + SC_U + swz128(wave * 16 + r, 2 * tb + (quad >> 1)) + (quad & 1) * 8);
        vn[tb][0] = bflo(uu.x) - acc[0]; vn[tb][1] = bfhi(uu.x) - acc[1]; vn[tb][2] = bflo(uu.y) - acc[2]; vn[tb][3] = bfhi(uu.y) - acc[3];
      }
      bf16x8 Vb[2];
      Vb[0] = pack_rows(vn[0], vn[1]); Vb[1] = pack_rows(vn[2], vn[3]);
#pragma unroll
      for (int tb = 0; tb < 4; ++tb) {
        f32x4 acc = {0.f, 0.f, 0.f, 0.f};
#pragma unroll
        for (int kk = 0; kk < 4; ++kk) acc = __builtin_amdgcn_mfma_f32_16x16x32_bf16(*(const bf16x8*)(B + SC_QD + swz256(16 * tb + r, 4 * kk + quad)), Sb[kk], acc, 0, 0, 0);
#pragma unroll
        for (int kt = 0; kt < 2; ++kt) acc = __builtin_amdgcn_mfma_f32_16x16x32_bf16(*(const bf16x8*)(B + SC_QA + swz128(16 * tb + r, 4 * kt + quad)), Vb[kt], acc, 0, 0, 0);
#pragma unroll
        for (int reg = 0; reg < 4; ++reg) odn[((size_t)b * SEQ + n * 64 + 16 * tb + 4 * quad + reg) * 1024 + h * 128 + e0 + r] = acc[reg];
      }
      const float egl = __int_as_float(__builtin_amdgcn_readlane(__float_as_int(eglv), n));
#pragma unroll
      for (int mb = 0; mb < 8; ++mb) {
        f32x4 acc = S[mb] * egl;
#pragma unroll
        for (int kt = 0; kt < 2; ++kt) acc = __builtin_amdgcn_mfma_f32_16x16x32_bf16(*(const bf16x8*)(B + SC_KT + swz128(16 * mb + r, 4 * kt + quad)), Vb[kt], acc, 0, 0, 0);
        S[mb] = acc;
      }
    }
  };
  if (wave >= 4) {
    u32x4 sta[16], stb[16];
    SC_LOAD(sta, chunk0); SC_LOAD(stb, chunk0 + 1); SC_STORE(sta, 0);
    for (int n = 0; n < 64; n += 2) {
      __syncthreads();
      if (n + 2 < 64) SC_LOAD(sta, chunk0 + n + 2);
      SC_STORE(stb, 1);
      __syncthreads();
      if (n + 3 < 64) SC_LOAD(stb, chunk0 + n + 3);
      if (n + 2 < 64) SC_STORE(sta, 0);
    }
  } else {
    for (int n = 0; n < 64; n += 2) {
      __syncthreads();
      compute(n);
      __syncthreads();
      compute(n + 1);
    }
  }
#undef SC_LOAD
#undef SC_STORE
#undef SC_OFF
#undef SC_SRC
}

DI void dn_final_phase(const Params& p) {
  const int TIDX = launder_tid();
  char* ws = p.ws;
  const float* odn = (const float*)(ws + OFF_ODN);
  const bf16_t* proj = (const bf16_t*)(ws + OFF_PROJ);
  bf16_t* mix = (bf16_t*)(ws + OFF_A);
  const int wave = TIDX >> 6, lane = TIDX & 63;
  const int dloc = (lane & 7) * 16;
  f32x4 gn[4];
#pragma unroll
  for (int i = 0; i < 4; ++i) gn[i] = *(const f32x4*)(p.dn_gain + dloc + 4 * i);
  for (int row = blockIdx.x * 8 + wave; row < NTOK; row += gridDim.x * 8) {
    f32x4 v[4]; float ss = 0.f;
#pragma unroll
    for (int i = 0; i < 4; ++i) { v[i] = *(const f32x4*)(odn + (size_t)row * 1024 + lane * 16 + 4 * i); ss += v[i][0] * v[i][0] + v[i][1] * v[i][1] + v[i][2] * v[i][2] + v[i][3] * v[i][3]; }
    ss += __shfl_xor(ss, 1); ss += __shfl_xor(ss, 2); ss += __shfl_xor(ss, 4);
    const float rs = rsqrtf(ss * (1.f / 128.f) + EPS);
    const u32x4 z0 = *(const u32x4*)(proj + (size_t)row * PROJ_N + 6144 + lane * 16), z1 = *(const u32x4*)(proj + (size_t)row * PROJ_N + 6144 + lane * 16 + 8);
    u32x4 o0, o1;
#pragma unroll
    for (int i = 0; i < 4; ++i) {
      const unsigned zz = i < 2 ? z0[2 * i] : z1[2 * (i - 2)], zz2 = i < 2 ? z0[2 * i + 1] : z1[2 * (i - 2) + 1];
      const float a = v[i][0] * rs * gn[i][0] * siluf_(bflo(zz)), c = v[i][1] * rs * gn[i][1] * siluf_(bfhi(zz));
      const float d = v[i][2] * rs * gn[i][2] * siluf_(bflo(zz2)), e = v[i][3] * rs * gn[i][3] * siluf_(bfhi(zz2));
      if (i < 2) { o0[2 * i] = pk_bf16(a, c); o0[2 * i + 1] = pk_bf16(d, e); } else { o1[2 * (i - 2)] = pk_bf16(a, c); o1[2 * (i - 2) + 1] = pk_bf16(d, e); }
    }
    *(u32x4*)(mix + (size_t)row * D_MODEL + 1024 + lane * 16) = o0; *(u32x4*)(mix + (size_t)row * D_MODEL + 1024 + lane * 16 + 8) = o1;
  }
}

DI void rows_mid_phase(const Params& p) {
  const int TIDX = launder_tid();
  char* ws = p.ws;
  const bf16_t* m = (const bf16_t*)(ws + OFF_M);
  bf16_t* hn = (bf16_t*)(ws + OFF_A);
  const int wave = TIDX >> 6, lane = TIDX & 63;
  for (int row = blockIdx.x * 8 + wave; row < NTOK; row += gridDim.x * 8) {
    f32x4 v[8]; float ss = 0.f;
#pragma unroll
    for (int i = 0; i < 8; ++i) { const u32x2 q = __builtin_nontemporal_load((const u32x2*)(m + (size_t)row * D_MODEL + 4 * (lane + 64 * i))); v[i] = (f32x4){bflo(q.x), bfhi(q.x), bflo(q.y), bfhi(q.y)}; ss += v[i][0] * v[i][0] + v[i][1] * v[i][1] + v[i][2] * v[i][2] + v[i][3] * v[i][3]; }
    ss = wave_sum(ss);
    const float rs = rsqrtf(ss * (1.f / D_MODEL) + EPS);
    float s2 = 0.f;
#pragma unroll
    for (int i = 0; i < 8; ++i) {
      const f32x4 g = *(const f32x4*)(p.ln_mix_post + 4 * (lane + 64 * i)), xv = __builtin_nontemporal_load((const f32x4*)(p.x + (size_t)row * D_MODEL + 4 * (lane + 64 * i)));
      v[i] = xv + v[i] * rs * g;
      s2 += v[i][0] * v[i][0] + v[i][1] * v[i][1] + v[i][2] * v[i][2] + v[i][3] * v[i][3];
    }
    s2 = wave_sum(s2);
    const float rs2 = rsqrtf(s2 * (1.f / D_MODEL) + EPS);
#pragma unroll
    for (int i = 0; i < 8; ++i) {
      const f32x4 g = *(const f32x4*)(p.ln_ffn_pre + 4 * (lane + 64 * i));
      const f32x4 y = v[i] * rs2 * g;
      u32x2 o; o.x = pk_bf16(y[0], y[1]); o.y = pk_bf16(y[2], y[3]);
      *(u32x2*)(hn + (size_t)row * D_MODEL + 4 * (lane + 64 * i)) = o;
    }
  }
}
DI void rows_final_phase(const Params& p) {
  const int TIDX = launder_tid();
  char* ws = p.ws;
  const bf16_t* f = (const bf16_t*)(ws + OFF_F);
  const bf16_t* m = (const bf16_t*)(ws + OFF_M);
  const int wave = TIDX >> 6, lane = TIDX & 63;
  for (int row = blockIdx.x * 8 + wave; row < NTOK; row += gridDim.x * 8) {
    f32x4 hv[8]; float s1 = 0.f;
#pragma unroll
    for (int i = 0; i < 8; ++i) { const u32x2 q = __builtin_nontemporal_load((const u32x2*)(m + (size_t)row * D_MODEL + 4 * (lane + 64 * i))); hv[i] = (f32x4){bflo(q.x), bfhi(q.x), bflo(q.y), bfhi(q.y)}; s1 += hv[i][0] * hv[i][0] + hv[i][1] * hv[i][1] + hv[i][2] * hv[i][2] + hv[i][3] * hv[i][3]; }
    s1 = wave_sum(s1);
    const float rs1 = rsqrtf(s1 * (1.f / D_MODEL) + EPS);
#pragma unroll
    for (int i = 0; i < 8; ++i) {
      const f32x4 g = *(const f32x4*)(p.ln_mix_post + 4 * (lane + 64 * i)), xv = __builtin_nontemporal_load((const f32x4*)(p.x + (size_t)row * D_MODEL + 4 * (lane + 64 * i)));
      hv[i] = xv + hv[i] * rs1 * g;
    }
    f32x4 v[8]; float ss = 0.f;
#pragma unroll
    for (int i = 0; i < 8; ++i) { const u32x2 q = __builtin_nontemporal_load((const u32x2*)(f + (size_t)row * D_MODEL + 4 * (lane + 64 * i))); v[i] = (f32x4){bflo(q.x), bfhi(q.x), bflo(q.y), bfhi(q.y)}; ss += v[i][0] * v[i][0] + v[i][1] * v[i][1] + v[i][2] * v[i][2] + v[i][3] * v[i][3]; }
    ss = wave_sum(ss);
    const float rs = rsqrtf(ss * (1.f / D_MODEL) + EPS);
#pragma unroll
    for (int i = 0; i < 8; ++i) {
      const f32x4 g = *(const f32x4*)(p.ln_ffn_post + 4 * (lane + 64 * i));
      __builtin_nontemporal_store(hv[i] + v[i] * rs * g, (f32x4*)(p.out + (size_t)row * D_MODEL + 4 * (lane + 64 * i)));
    }
  }
}

DI void fast_grid_barrier(unsigned* bar, unsigned k) {
  asm volatile("s_waitcnt vmcnt(0) lgkmcnt(0)" ::: "memory");
  __syncthreads();
  if (threadIdx.x == 0) {
    const unsigned g = blockIdx.x & 7u, per_group = gridDim.x >> 3;
    unsigned* sub = bar + 64 * (1 + g); unsigned* gen = bar + 64 * (9 + g); unsigned* top = bar;
    __builtin_amdgcn_fence(__ATOMIC_RELEASE, "agent");
    asm volatile("s_waitcnt vmcnt(0)" ::: "memory");
    const unsigned old = __hip_atomic_fetch_add(sub, 1u, __ATOMIC_RELAXED, __HIP_MEMORY_SCOPE_AGENT);
    if (old + 1u == k * per_group) {
      __hip_atomic_fetch_add(top, 1u, __ATOMIC_RELAXED, __HIP_MEMORY_SCOPE_AGENT);
      while (__hip_atomic_load(top, __ATOMIC_RELAXED, __HIP_MEMORY_SCOPE_AGENT) < 8u * k) __builtin_amdgcn_s_sleep(1);
      __hip_atomic_store(gen, k, __ATOMIC_RELAXED, __HIP_MEMORY_SCOPE_AGENT);
    } else {
      while (__hip_atomic_load(gen, __ATOMIC_RELAXED, __HIP_MEMORY_SCOPE_AGENT) < k) __builtin_amdgcn_s_sleep(1);
    }
    __builtin_amdgcn_fence(__ATOMIC_ACQUIRE, "agent");
    asm volatile("s_waitcnt vmcnt(0)" ::: "memory");
  }
  __syncthreads();
}
#define CAS __attribute__((address_space(4)))
DI Params load_params() {
#if !defined(__HIP_DEVICE_COMPILE__)
  return Params{};
#else
  const CAS char* base = (const CAS char*)__builtin_amdgcn_kernarg_segment_ptr();
  asm volatile("" : "+s"(base));
  return *(const CAS Params*)base;
#endif
}
#ifndef ONLY_PHASE
#define ONLY_PHASE -1
#endif
#define PH_EN(n) (ONLY_PHASE < 0 || ONLY_PHASE == (n))
__global__ void __launch_bounds__(NTHREADS) fwd_megakernel(Params pk) {
  extern __shared__ __attribute__((aligned(16))) char smem[];
  cg::grid_group grid = cg::this_grid();
#ifndef PROBE_SB
#define PROBE_SB 1
#endif
#ifndef PROBE_PHASE
#define PROBE_PHASE -1
#endif
#define PHASE(n) if (PH_EN(n) && pk.phase_begin <= (n) && (n) < pk.phase_end) for (int rep_ = 0; rep_ < ((n) == PROBE_PHASE ? 2 : 1); ++rep_)
#define SYNC(n) if ((n) > pk.phase_begin && rep_ == 0) { fast_grid_barrier((unsigned*)(pk.ws + OFF_BAR), (unsigned)((n) - pk.phase_begin)); } if (rep_ > 0) __syncthreads(); const Params p = load_params(); char* ws = p.ws; (void)ws
  if (pk.phase_begin > 1000) grid.sync();
  PHASE(0) { SYNC(0); prep_phase(p, smem); }
  PHASE(1) { SYNC(1); gemm_phase<0>(p, (const bf16_t*)(ws + OFF_A), (const bf16_t*)(ws + OFF_WINT), NTOK, PROJ_N, 2048, ws + OFF_PROJ, nullptr, smem); }
  PHASE(2) { SYNC(2);
#if DN_V1
    for (int c = blockIdx.x; c < NCHUNK; c += gridDim.x) dn_chunk(p, c, smem);
    __syncthreads();
#endif
#if DN_V1 != 1
    { const int wave = launder_tid() >> 6;
      for (int c = blockIdx.x * 8 + wave; c < NCHUNK; c += gridDim.x * 8) dn_chunk_wave(p, c, smem); }
#endif
  }
  PHASE(3) { SYNC(3); const int TIDX = launder_tid();
    for (int u = blockIdx.x; u < 64; u += gridDim.x) { dn_scan_block(p, u, smem); __syncthreads(); }
    unsigned* qctr = (unsigned*)(ws + OFF_QCTR);
    const int wave = TIDX >> 6;
    bf16_t* vl = (bf16_t*)(smem + 64) + wave * (32 * VS_LD);
    constexpr int SB_UNITS = BATCH * 8 * 128 / 8;
    for (;;) {
      __syncthreads();
      if (TIDX == 0) *(volatile unsigned*)smem = atomicAdd(qctr, 1u);
      __syncthreads();
      const unsigned item = *(volatile unsigned*)smem;
      if (item >= (unsigned)(SB_UNITS + CONV_UNITS)) break;
      if (item < (unsigned)SB_UNITS) sb_unit(p, (int)item * 8 + wave, vl);
      else { __syncthreads(); convert_unit(p, (int)item - SB_UNITS, smem); }
    }
  }
  PHASE(4) { SYNC(4); dn_final_phase(p); }
  PHASE(5) { SYNC(5); gemm_phase<1>(p, (const bf16_t*)(ws + OFF_A), (const bf16_t*)(ws + OFF_WOUTT), NTOK, 2048, 2048, ws + OFF_M, nullptr, smem); }
  PHASE(6) { SYNC(6); rows_mid_phase(p); }
  PHASE(7) { SYNC(7); gemm_phase<2>(p, (const bf16_t*)(ws + OFF_A), (const bf16_t*)(ws + OFF_WUPT), NTOK, UP_N, 2048, ws + OFF_ACT, (bf16_t*)(ws + OFF_HALO), smem); }
  PHASE(8) { SYNC(8); ffn_fix_phase(p, (const bf16_t*)(ws + OFF_HALO), (bf16_t*)(ws + OFF_ACT)); }
  PHASE(9) { SYNC(9); gemm_phase<1>(p, (const bf16_t*)(ws + OFF_ACT), (const bf16_t*)(ws + OFF_WDOWNT), NTOK, 2048, D_FF, ws + OFF_F, nullptr, smem); }
  PHASE(10) { SYNC(10);
#ifdef PROBE_SYNCS
    for (int i_ = 0; i_ < 10; ++i_) fast_grid_barrier((unsigned*)(pk.ws + OFF_BAR), (unsigned)(10 + i_));
#endif
    rows_final_phase(p); }
}

constexpr int NPHASES = 11;
#ifndef MK_SINGLE_LAUNCH
#define MK_SINGLE_LAUNCH 1
#endif

extern "C" void kernel_launch(void* const* d_in, const int* in_sizes, int n_in, void* d_out, int out_size, void* d_ws, size_t ws_size, hipStream_t stream) {
  static int grid_blocks = 0;
  if (!grid_blocks) {
    hipFuncSetAttribute((const void*)fwd_megakernel, hipFuncAttributeMaxDynamicSharedMemorySize, LDS_BYTES);
    int dev = 0, cus = 0, per_cu = 0;
    hipGetDevice(&dev);
    hipDeviceGetAttribute(&cus, hipDeviceAttributeMultiprocessorCount, dev);
    hipOccupancyMaxActiveBlocksPerMultiprocessor(&per_cu, fwd_megakernel, NTHREADS, LDS_BYTES);
    if (per_cu < 1) per_cu = 1;
    if (per_cu > 1) per_cu = 1;
    grid_blocks = cus * per_cu;
    if (grid_blocks > 256) grid_blocks = 256;
    grid_blocks &= ~7;
  }
  Params p{};
  p.x = (const float*)d_in[0]; p.w_in = (const float*)d_in[1]; p.sb_gain = (const float*)d_in[2]; p.dn_conv_w = (const float*)d_in[3];
  p.dn_a_log = (const float*)d_in[4]; p.dn_dt_bias = (const float*)d_in[5]; p.dn_gain = (const float*)d_in[6]; p.w_out = (const float*)d_in[7];
  p.ln_mix_pre = (const float*)d_in[8]; p.ln_mix_post = (const float*)d_in[9]; p.w_up = (const float*)d_in[10]; p.ffn_conv_w = (const float*)d_in[11];
  p.ffn_conv_b = (const float*)d_in[12]; p.w_down = (const float*)d_in[13]; p.ln_ffn_pre = (const float*)d_in[14]; p.ln_ffn_post = (const float*)d_in[15];
  p.out = (float*)d_out; p.ws = (char*)d_ws;
#if MK_SINGLE_LAUNCH
  p.phase_begin = 0; p.phase_end = NPHASES;
  hipMemsetAsync((char*)d_ws + OFF_BAR, 0, 17 * 256, stream);
  void* args[] = {&p};
  hipError_t e = hipLaunchCooperativeKernel((const void*)fwd_megakernel, dim3(grid_blocks), dim3(NTHREADS), args, LDS_BYTES, stream);
  if (e != hipSuccess) fprintf(stderr, "cooperative launch failed: %s (grid %d)\n", hipGetErrorString(e), grid_blocks);
#else
  for (int ph = 0; ph < NPHASES; ++ph) {
    p.phase_begin = ph; p.phase_end = ph + 1;
    hipLaunchKernelGGL(fwd_megakernel, dim3(grid_blocks), dim3(NTHREADS), LDS_BYTES, stream, p);
  }
#endif
}
```

```cpp
#include <hip/hip_runtime.h>
#include <hip/hip_cooperative_groups.h>
#include <cstdio>
namespace cg = cooperative_groups;

typedef unsigned short bf16_t;
typedef short bf16x8 __attribute__((ext_vector_type(8)));
typedef float f32x4 __attribute__((ext_vector_type(4)));
typedef float f32x16 __attribute__((ext_vector_type(16)));
typedef unsigned u32x4 __attribute__((ext_vector_type(4)));
typedef unsigned u32x2 __attribute__((ext_vector_type(2)));
#define DI __device__ __forceinline__

constexpr int D_MODEL = 2048, BATCH = 4, SEQ = 4096, NTOK = BATCH * SEQ;
constexpr int PROJ_N = 7168;
constexpr int IN_COLS = 7184;
constexpr int D_FF = 5632, UP_N = 2 * D_FF;
constexpr int NCHUNK = BATCH * 8 * 64;
constexpr float EPS = 1e-6f;
constexpr int NTHREADS = 512;
constexpr int CS_LD = 264;
constexpr int LDS_BYTES = 163840;
#ifndef DN_V1
#define DN_V1 0
#endif

constexpr size_t MiB = 1024ull * 1024ull;
constexpr size_t OFF_WUPT = 0, OFF_WDOWNT = 44 * MiB, OFF_A = 66 * MiB, OFF_WINT = 130 * MiB, OFF_WOUTT = 158 * MiB,
                 OFF_EXT = 166 * MiB, OFF_GL = 167 * MiB, OFF_QCTR = 167 * MiB + 65536, OFF_BAR = 167 * MiB + 65536 + 1024, OFF_HALO = 168 * MiB, OFF_PROJ = 174 * MiB, OFF_QA = 398 * MiB,
                 OFF_ODN = 414 * MiB, OFF_M = 414 * MiB  , OFF_ACT = 174 * MiB, OFF_F = 350 * MiB;

struct Params {
  const float* x; const float* w_in; const float* sb_gain; const float* dn_conv_w; const float* dn_a_log; const float* dn_dt_bias;
  const float* dn_gain; const float* w_out; const float* ln_mix_pre; const float* ln_mix_post; const float* w_up; const float* ffn_conv_w;
  const float* ffn_conv_b; const float* w_down; const float* ln_ffn_pre; const float* ln_ffn_post;
  float* out; char* ws;
  int phase_begin, phase_end;
};

typedef float f32x2_t __attribute__((ext_vector_type(2)));
typedef __bf16 bf16x2_t __attribute__((ext_vector_type(2)));
DI unsigned pk_bf16_mfma(float lo, float hi) { const f32x2_t v = {lo, hi}; return __builtin_bit_cast(unsigned, __builtin_convertvector(v, bf16x2_t)); }
DI unsigned pk_bf16(float lo, float hi) { unsigned r; asm("v_cvt_pk_bf16_f32 %0, %1, %2" : "=v"(r) : "v"(lo), "v"(hi)); return r; }
DI float bf2f(bf16_t v) { return __uint_as_float(((unsigned)v) << 16); }
DI float bflo(unsigned v) { return __uint_as_float(v << 16); }
DI float bfhi(unsigned v) { return __uint_as_float(v & 0xffff0000u); }
DI float wave_sum(float v) {
#pragma unroll
  for (int o = 32; o >= 1; o >>= 1) v += __shfl_xor(v, o);
  return v;
}
DI float sigmoidf_(float x) { return __builtin_amdgcn_rcpf(1.f + __expf(-x)); }
DI float siluf_(float x) { return x * __builtin_amdgcn_rcpf(1.f + __expf(-x)); }
DI float softplusf_(float x) { return fmaxf(x, 0.f) + __logf(1.f + __expf(-fabsf(x))); }
DI float gelu_tanh(float x) { float u = 0.7978845608028654f * (x + 0.044715f * x * x * x); return x * __builtin_amdgcn_rcpf(1.f + __expf(-2.f * u)); }
DI int launder_tid() { int t = threadIdx.x; asm volatile("" : "+v"(t)); return t; }
DI void wave_lds_sync() { asm volatile("s_waitcnt lgkmcnt(0)" ::: "memory"); __builtin_amdgcn_wave_barrier(); }

constexpr int BM = 256, BK = 64, HALF = 128, NXCD = 8, WGM = 8, HT = HALF * BK;
DI int lds_byte(int r, int c) { int st = (r >> 4) * 2 + (c >> 5), rr = r & 15, cc = c & 31, ob = rr * 64 + cc * 2; return st * 1024 + (ob ^ (((ob >> 9) & 1) << 5)); }
DI void stage_rc(int b, int& R, int& C) { int st = b / 1024, sb = b % 1024, swz = sb ^ (((sb >> 9) & 1) << 5); R = (st >> 1) * 16 + swz / 64; C = (st & 1) * 32 + (swz % 64) / 2; }

#define LAS __attribute__((address_space(3)))
constexpr int HTB = HT * 2;
DI void gemm_tile(const bf16_t* __restrict__ A, const bf16_t* __restrict__ Bt, int K, int brow, int bcol, LAS unsigned char* lds, f32x4 (&acc)[2][2][4][2]) {
  const int TIDX = launder_tid();
  const int tid = TIDX, wid = __builtin_amdgcn_readfirstlane(tid >> 6), lane = tid & 63, wr = wid >> 2, wc = wid & 3, fr = lane & 15, fq = lane >> 4;
  const int nt = K / BK;
  unsigned voff[2];
#pragma unroll
  for (int i = 0; i < 2; ++i) { int R, C; stage_rc(tid * 16 + i * 8192, R, C); voff[i] = (unsigned)(R * K + C) * 2u; }
  const size_t kstep = (size_t)(BK * 2), hstep = (size_t)HALF * K * 2;
  const unsigned ldsw = (unsigned)wid * 1024u;
  const int aoff = lds_byte(wr * 64 + fr, fq * 8), boff = lds_byte(wc * 32 + fr, fq * 8);
#define SA(b, h) (((b) * 2 + (h)) * HTB)
#define SB(b, h) ((4 + (b) * 2 + (h)) * HTB)
#define STAGE(bufoff, gbase) do { _Pragma("unroll") for (int _i = 0; _i < 2; ++_i) \
    __builtin_amdgcn_global_load_lds((const unsigned*)((const char*)(gbase) + voff[_i]), (LAS unsigned*)(lds + (bufoff) + ldsw + _i * 8192), 16, 0, 0); } while (0)
#define LDA(dst, b, h) do { _Pragma("unroll") for (int m = 0; m < 4; ++m) _Pragma("unroll") for (int k = 0; k < 2; ++k) dst[m][k] = *(const LAS bf16x8*)(lds + SA(b, h) + aoff + m * 2048 + k * 1024); } while (0)
#define LDB(dst, b, h) do { _Pragma("unroll") for (int n = 0; n < 2; ++n) _Pragma("unroll") for (int k = 0; k < 2; ++k) dst[n][k] = *(const LAS bf16x8*)(lds + SB(b, h) + boff + n * 2048 + k * 1024); } while (0)
#define MMA(ai, bj, At, Bq) do { __builtin_amdgcn_s_setprio(1); _Pragma("unroll") for (int m = 0; m < 4; ++m) _Pragma("unroll") for (int n = 0; n < 2; ++n) _Pragma("unroll") for (int k = 0; k < 2; ++k) \
      acc[ai][bj][m][n] = __builtin_amdgcn_mfma_f32_16x16x32_bf16(Bq[n][k], At[m][k], acc[ai][bj][m][n], 0, 0, 0); \
    __builtin_amdgcn_s_setprio(0); } while (0)
#define WAIT_V(n) asm volatile("s_waitcnt vmcnt(" #n ")" ::: "memory")
#define WAIT_L(n) asm volatile("s_waitcnt lgkmcnt(" #n ")" ::: "memory")
#define BAR __builtin_amdgcn_s_barrier()
#define SCHED __builtin_amdgcn_sched_barrier(0)
#pragma unroll
  for (int a = 0; a < 2; ++a)
#pragma unroll
    for (int b = 0; b < 2; ++b)
#pragma unroll
      for (int m = 0; m < 4; ++m)
#pragma unroll
        for (int n = 0; n < 2; ++n) acc[a][b][m][n] = (f32x4){0.f, 0.f, 0.f, 0.f};
  bf16x8 At[4][2], B0[2][2], B1[2][2];
  const char* cA = (const char*)A + (size_t)brow * K * 2; const char* cB = (const char*)Bt + (size_t)bcol * K * 2;
  STAGE(SB(0, 0), cB); STAGE(SA(0, 0), cA); STAGE(SB(0, 1), cB + hstep); STAGE(SA(0, 1), cA + hstep);
  if (wr == 1) BAR;
  WAIT_V(4); BAR;
  STAGE(SB(1, 0), cB + kstep); STAGE(SA(1, 0), cA + kstep); STAGE(SB(1, 1), cB + hstep + kstep);
  WAIT_V(6); BAR;
  for (int t = 0; t < nt - 2; t += 2) {
    const char* a1 = cA + (size_t)(t + 1) * kstep;
    const char* a2 = cA + (size_t)(t + 2) * kstep; const char* b2 = cB + (size_t)(t + 2) * kstep;
    const char* a3 = a2 + kstep; const char* b3 = b2 + kstep;
    LDB(B0, 0, 0); SCHED; LDA(At, 0, 0); STAGE(SA(1, 1), a1 + hstep);
    WAIT_L(8); BAR; WAIT_L(0); MMA(0, 0, At, B0); BAR; SCHED;
    LDB(B1, 0, 1); STAGE(SB(0, 0), b2);
    BAR; WAIT_L(0); MMA(0, 1, At, B1); BAR;
    LDA(At, 0, 1); STAGE(SA(0, 0), a2);
    BAR; WAIT_L(0); MMA(1, 0, At, B0); BAR; SCHED;
    STAGE(SB(0, 1), b2 + hstep);
    WAIT_V(6); BAR; MMA(1, 1, At, B1); BAR;
    LDB(B0, 1, 0); SCHED; LDA(At, 1, 0); STAGE(SA(0, 1), a2 + hstep);
    WAIT_L(8); BAR; WAIT_L(0); MMA(0, 0, At, B0); BAR; SCHED;
    LDB(B1, 1, 1); STAGE(SB(1, 0), b3);
    BAR; WAIT_L(0); MMA(0, 1, At, B1); BAR;
    LDA(At, 1, 1); STAGE(SA(1, 0), a3);
    BAR; WAIT_L(0); MMA(1, 0, At, B0); BAR; SCHED;
    STAGE(SB(1, 1), b3 + hstep);
    WAIT_V(6); BAR; MMA(1, 1, At, B1); BAR;
  }
  { LDB(B0, 0, 0); LDA(At, 0, 0); STAGE(SA(1, 1), cA + (size_t)(nt - 1) * kstep + hstep);
    BAR; WAIT_L(0); MMA(0, 0, At, B0); BAR;
    LDB(B1, 0, 1); BAR; WAIT_L(0); MMA(0, 1, At, B1); BAR;
    LDA(At, 0, 1); WAIT_V(4); BAR; WAIT_L(0); MMA(1, 0, At, B0); MMA(1, 1, At, B1); BAR; }
  { LDB(B0, 1, 0); LDA(At, 1, 0); WAIT_V(2); BAR; WAIT_L(0); MMA(0, 0, At, B0); BAR;
    LDB(B1, 1, 1); WAIT_V(0); BAR; WAIT_L(0); MMA(0, 1, At, B1); BAR;
    LDA(At, 1, 1); BAR; WAIT_L(0); MMA(1, 0, At, B0); MMA(1, 1, At, B1); BAR; }
  if (wr == 0) BAR;
#undef SA
#undef SB
#undef STAGE
#undef LDA
#undef LDB
#undef MMA
}

DI void tile_of(int L, int nM, int nN, int& pm, int& pn) {
  const int nwg = nM * nN;
  int wgid = L; { const int q = nwg / NXCD, r = nwg % NXCD, xcd = wgid % NXCD, off = wgid / NXCD; wgid = (xcd < r ? xcd * (q + 1) : r * (q + 1) + (xcd - r) * q) + off; }
  const int nig = WGM * nN, gid = wgid / nig, fm = gid * WGM, gsz = (nM - fm) < WGM ? (nM - fm) : WGM;
  pm = fm + ((wgid % nig) % gsz); pn = (wgid % nig) / gsz;
}

DI void stage_c_bf16(const f32x4 (&acc)[2][2][4][2], bf16_t* Cs) {
  const int TIDX = launder_tid();
  const int wid = TIDX >> 6, lane = TIDX & 63, wr = wid >> 2, wc = wid & 3, fr = lane & 15, fq = lane >> 4;
#pragma unroll
  for (int ai = 0; ai < 2; ++ai)
#pragma unroll
    for (int bj = 0; bj < 2; ++bj)
#pragma unroll
      for (int m = 0; m < 4; ++m)
#pragma unroll
        for (int n = 0; n < 2; ++n) {
          const int row = ai * 128 + wr * 64 + m * 16 + fr, col = bj * 128 + wc * 32 + n * 16 + 4 * fq;
          u32x2 v; v.x = pk_bf16_mfma(acc[ai][bj][m][n][0], acc[ai][bj][m][n][1]); v.y = pk_bf16_mfma(acc[ai][bj][m][n][2], acc[ai][bj][m][n][3]);
          *(u32x2*)(Cs + row * CS_LD + col) = v;
        }
}

template <int EPI>
DI void gemm_phase(const Params& p, const bf16_t* A, const bf16_t* Bt, int M, int N, int K, void* outp, bf16_t* halo, char* smem) {
  const int TIDX = launder_tid();
  const int nM = M / BM, nN = N / BM, nwg = nM * nN;
  bf16_t* shm = (bf16_t*)smem;
  for (int L = blockIdx.x; L < nwg; L += gridDim.x) {
    int pm, pn; tile_of(L, nM, nN, pm, pn);
    const int brow = pm * BM, bcol = pn * BM;
    f32x4 acc[2][2][4][2];
    gemm_tile(A, Bt, K, brow, bcol, (LAS unsigned char*)smem, acc);
    if (EPI == 1) {
      bf16_t* O = (bf16_t*)outp;
      const int wid = TIDX >> 6, lane = TIDX & 63, wr = wid >> 2, wc = wid & 3, fr = lane & 15, fq = lane >> 4;
#pragma unroll
      for (int ai = 0; ai < 2; ++ai)
#pragma unroll
        for (int m = 0; m < 4; ++m) {
          bf16_t* rowp = O + (size_t)(brow + ai * 128 + wr * 64 + m * 16 + fr) * N + bcol + wc * 32 + 4 * fq;
#pragma unroll
          for (int bj = 0; bj < 2; ++bj)
#pragma unroll
            for (int n = 0; n < 2; ++n) { u32x2 v; v.x = pk_bf16_mfma(acc[ai][bj][m][n][0], acc[ai][bj][m][n][1]); v.y = pk_bf16_mfma(acc[ai][bj][m][n][2], acc[ai][bj][m][n][3]); *(u32x2*)(rowp + bj * 128 + n * 16) = v; }
        }
    } else {
      bf16_t* Cs = shm;
      stage_c_bf16(acc, Cs);
      __syncthreads();
      if (EPI == 0) {
        bf16_t* O = (bf16_t*)outp;
#pragma unroll 4
        for (int i = 0; i < 16; ++i) {
          const int id = TIDX + NTHREADS * i, row = id >> 5, ch = id & 31;
          const u32x4 v = *(const u32x4*)(Cs + row * CS_LD + ch * 8);
          *(u32x4*)(O + (size_t)(brow + row) * N + bcol + ch * 8) = v;
        }
      } else {
        bf16_t* ACT = (bf16_t*)outp;
        const int cgp = TIDX & 15, r0 = TIDX >> 4;
        const int gcol = pn * 128 + cgp * 8;
        float wg[3][8], wv[3][8], bg[8], bv[8];
#pragma unroll
        for (int k = 0; k < 3; ++k)
#pragma unroll
          for (int c = 0; c < 8; ++c) { wg[k][c] = p.ffn_conv_w[k * UP_N + gcol + c]; wv[k][c] = p.ffn_conv_w[k * UP_N + D_FF + gcol + c]; }
#pragma unroll
        for (int c = 0; c < 8; ++c) { bg[c] = p.ffn_conv_b[gcol + c]; bv[c] = p.ffn_conv_b[D_FF + gcol + c]; }
        const bool seq_start = (brow % SEQ) == 0;
        for (int i = 0; i < 8; ++i) {
          const int row = r0 + 32 * i;
          if (row < 2 && !seq_start) continue;
          float g[8], v[8];
#pragma unroll
          for (int c = 0; c < 8; ++c) { g[c] = bg[c]; v[c] = bv[c]; }
#pragma unroll
          for (int k = 0; k < 3; ++k) {
            const int rr = row - 2 + k;
            if (rr < 0) continue;
            const u32x4 gq = *(const u32x4*)(Cs + rr * CS_LD + cgp * 8);
            const u32x4 vq = *(const u32x4*)(Cs + rr * CS_LD + 128 + cgp * 8);
#pragma unroll
            for (int c2 = 0; c2 < 4; ++c2) {
              g[2 * c2] += wg[k][2 * c2] * bflo(gq[c2]); g[2 * c2 + 1] += wg[k][2 * c2 + 1] * bfhi(gq[c2]);
              v[2 * c2] += wv[k][2 * c2] * bflo(vq[c2]); v[2 * c2 + 1] += wv[k][2 * c2 + 1] * bfhi(vq[c2]);
            }
          }
          u32x4 o;
#pragma unroll
          for (int c2 = 0; c2 < 4; ++c2) o[c2] = pk_bf16(gelu_tanh(g[2 * c2]) * v[2 * c2], gelu_tanh(g[2 * c2 + 1]) * v[2 * c2 + 1]);
          *(u32x4*)(ACT + (size_t)(brow + row) * D_FF + gcol) = o;
        }
        if (TIDX < 128) {
          const int slot = TIDX >> 5, ch = TIDX & 31;
          const int row = slot < 2 ? slot : 252 + slot;
          *(u32x4*)(halo + ((size_t)(pm * 4 + slot) * UP_N) + pn * 256 + ch * 8) = *(const u32x4*)(Cs + row * CS_LD + ch * 8);
        }
      }
    }
    __syncthreads();
  }
}

DI void ffn_fix_phase(const Params& p, const bf16_t* halo, bf16_t* ACT) {
  const int TIDX = launder_tid();
  const int total = 64 * 2 * 44 * 16;
  for (int id = blockIdx.x * NTHREADS + TIDX; id < total; id += gridDim.x * NTHREADS) {
    const int cgp = id & 15; int t = id >> 4; const int pn = t % 44; t /= 44; const int rr = t & 1; const int pm = t >> 1;
    if ((pm & 15) == 0) continue;
    const int gcol = pn * 128 + cgp * 8;
    float g[8], v[8];
#pragma unroll
    for (int c = 0; c < 8; ++c) { g[c] = p.ffn_conv_b[gcol + c]; v[c] = p.ffn_conv_b[D_FF + gcol + c]; }
#pragma unroll
    for (int k = 0; k < 3; ++k) {
      const int r = rr - 2 + k;
      const bf16_t* src = r < 0 ? halo + (size_t)((pm - 1) * 4 + 4 + r) * UP_N : halo + (size_t)(pm * 4 + r) * UP_N;
      const u32x4 gq = *(const u32x4*)(src + pn * 256 + cgp * 8);
      const u32x4 vq = *(const u32x4*)(src + pn * 256 + 128 + cgp * 8);
#pragma unroll
      for (int c2 = 0; c2 < 4; ++c2) {
        g[2 * c2] += p.ffn_conv_w[k * UP_N + gcol + 2 * c2] * bflo(gq[c2]); g[2 * c2 + 1] += p.ffn_conv_w[k * UP_N + gcol + 2 * c2 + 1] * bfhi(gq[c2]);
        v[2 * c2] += p.ffn_conv_w[k * UP_N + D_FF + gcol + 2 * c2] * bflo(vq[c2]); v[2 * c2 + 1] += p.ffn_conv_w[k * UP_N + D_FF + gcol + 2 * c2 + 1] * bfhi(vq[c2]);
      }
    }
    u32x4 o;
#pragma unroll
    for (int c2 = 0; c2 < 4; ++c2) o[c2] = pk_bf16(gelu_tanh(g[2 * c2]) * v[2 * c2], gelu_tanh(g[2 * c2 + 1]) * v[2 * c2 + 1]);
    *(u32x4*)(ACT + (size_t)(pm * 256 + rr) * D_FF + gcol) = o;
  }
}

DI void transpose_group(const float* __restrict__ src, int ld_src, int K, int mode, bf16_t* __restrict__ dst, char* smem, int group) {
  const int TIDX = launder_tid();
  bf16_t* T = (bf16_t*)smem;
  const int gk = K / 256, tk4 = group % gk, tn = group / gk;
  int scol = tn * 64;
  if (mode == 1) { const int nt = tn >> 2, sub = tn & 3; scol = (sub < 2 ? 0 : D_FF) + nt * 128 + (sub & 1) * 64; }
  const int kq = TIDX >> 4, n4 = (TIDX & 15) * 4;
  f32x4 v[8];
#pragma unroll
  for (int i = 0; i < 8; ++i) v[i] = __builtin_nontemporal_load((const f32x4*)(src + (size_t)(tk4 * 256 + kq + 32 * i) * ld_src + scol + n4));
#pragma unroll
  for (int i = 0; i < 8; ++i) {
    const int k = kq + 32 * (i & 1); bf16_t* Tq = T + (i >> 1) * (64 * 72);
    const unsigned a = pk_bf16(v[i][0], v[i][1]), b = pk_bf16(v[i][2], v[i][3]);
    Tq[(n4 + 0) * 72 + k] = (bf16_t)(a & 0xffff); Tq[(n4 + 1) * 72 + k] = (bf16_t)(a >> 16);
    Tq[(n4 + 2) * 72 + k] = (bf16_t)(b & 0xffff); Tq[(n4 + 3) * 72 + k] = (bf16_t)(b >> 16);
  }
  __syncthreads();
  { const int n = TIDX >> 3, k8 = (TIDX & 7) * 8;
#pragma unroll
    for (int q = 0; q < 4; ++q) *(u32x4*)(dst + (size_t)(tn * 64 + n) * K + tk4 * 256 + q * 64 + k8) = *(const u32x4*)(T + q * (64 * 72) + n * 72 + k8); }
  __syncthreads();
}
constexpr int CONV_UNITS = (256 + 1408 + 704) / 4;
DI void convert_unit(const Params& p, int unit, char* smem) {
  char* ws = p.ws;
#pragma unroll 1
  for (int q = 0; q < 4; ++q) {
    int g = unit * 4 + q;
    if (g < 256) transpose_group(p.w_out, 2048, 2048, 0, (bf16_t*)(ws + OFF_WOUTT), smem, g);
    else if (g < 256 + 1408) transpose_group(p.w_up, UP_N, 2048, 1, (bf16_t*)(ws + OFF_WUPT), smem, g - 256);
    else transpose_group(p.w_down, 2048, 5632, 0, (bf16_t*)(ws + OFF_WDOWNT), smem, g - 256 - 1408);
  }
}

DI void prep_phase(const Params& p, char* smem) {
  const int TIDX = launder_tid();
  char* ws = p.ws;
  if (blockIdx.x == 0 && TIDX == 0) *(unsigned*)(ws + OFF_QCTR) = 0u;
  for (int g = blockIdx.x; g < 8 * 112; g += gridDim.x) transpose_group(p.w_in, IN_COLS, 2048, 0, (bf16_t*)(ws + OFF_WINT), smem, g);
  __syncthreads();
  float* Wl = (float*)smem;
  for (int i = TIDX; i < 2048 * 16; i += NTHREADS) { const int d = i >> 4, j = i & 15; Wl[j * 2048 + d] = p.w_in[(size_t)d * IN_COLS + PROJ_N + j]; }
  __syncthreads();
  const int wave = TIDX >> 6, lane = TIDX & 63;
  bf16_t* xn = (bf16_t*)(ws + OFF_A);
  float* ext = (float*)(ws + OFF_EXT);
  for (int row0 = 2 * (blockIdx.x * 8 + wave); row0 < NTOK; row0 += 2 * gridDim.x * 8) {
    f32x4 v[2][8]; float ss[2] = {0.f, 0.f};
#pragma unroll
    for (int q = 0; q < 2; ++q)
#pragma unroll
      for (int i = 0; i < 8; ++i) { v[q][i] = __builtin_nontemporal_load((const f32x4*)(p.x + (size_t)(row0 + q) * D_MODEL + 4 * (lane + 64 * i))); ss[q] += v[q][i][0] * v[q][i][0] + v[q][i][1] * v[q][i][1] + v[q][i][2] * v[q][i][2] + v[q][i][3] * v[q][i][3]; }
#pragma unroll
    for (int q = 0; q < 2; ++q) {
      const float rs = rsqrtf(wave_sum(ss[q]) * (1.f / D_MODEL) + EPS);
#pragma unroll
      for (int i = 0; i < 8; ++i) {
        const f32x4 g = *(const f32x4*)(p.ln_mix_pre + 4 * (lane + 64 * i));
        v[q][i] = v[q][i] * rs * g;
        u32x2 o; o.x = pk_bf16(v[q][i][0], v[q][i][1]); o.y = pk_bf16(v[q][i][2], v[q][i][3]);
        *(u32x2*)(xn + (size_t)(row0 + q) * D_MODEL + 4 * (lane + 64 * i)) = o;
      }
    }
    float myv0 = 0.f, myv1 = 0.f;
#pragma unroll 1
    for (int j = 0; j < 16; ++j) {
      float a0 = 0.f, a1 = 0.f;
#pragma unroll
      for (int i = 0; i < 8; ++i) { const f32x4 w = *(const f32x4*)(Wl + j * 2048 + 4 * (lane + 64 * i));
        a0 += v[0][i][0] * w[0] + v[0][i][1] * w[1] + v[0][i][2] * w[2] + v[0][i][3] * w[3];
        a1 += v[1][i][0] * w[0] + v[1][i][1] * w[1] + v[1][i][2] * w[2] + v[1][i][3] * w[3]; }
      a0 = wave_sum(a0); a1 = wave_sum(a1);
      if (lane == j) { myv0 = a0; myv1 = a1; }
    }
    if (lane < 16) { ext[(size_t)row0 * 16 + lane] = myv0; ext[(size_t)(row0 + 1) * 16 + lane] = myv1; }
  }
}

DI int permcol(int c) { const int g = (c >> 2) & 7; const int ng = g < 4 ? 2 * g : 2 * (g - 4) + 1; return (c & ~31) | (ng << 2) | (c & 3); }
constexpr int QS_LD = 132, LM_LD = 68;
DI void dn_chunk(const Params& p, int chunk, char* smem) {
  const int TIDX = launder_tid();
  char* ws = p.ws;
  const bf16_t* proj = (const bf16_t*)(ws + OFF_PROJ);
  const float* ext = (const float*)(ws + OFF_EXT);
  bf16_t* Ug = (bf16_t*)p.out;
  bf16_t* Wg = Ug + (size_t)NCHUNK * 8192; bf16_t* QDg = Wg + (size_t)NCHUNK * 8192; bf16_t* KTg = QDg + (size_t)NCHUNK * 8192;
  bf16_t* QAg = (bf16_t*)(ws + OFF_QA);
  float* GL = (float*)(ws + OFF_GL);
  float* qs = (float*)smem; float* ks = qs + 64 * QS_LD; float* vs = ks + 64 * QS_LD; float* Lm = vs + 64 * QS_LD;
  float* gcs = Lm + 64 * LM_LD; float* betas = gcs + 64;
  const int bh = chunk >> 6, n = chunk & 63, b = bh >> 3, h = bh & 7;
  const int tid = TIDX, wave = tid >> 6, lane = tid & 63;
  const size_t tok0 = (size_t)b * SEQ + n * 64;
#ifndef PROBE_DN123
#define PROBE_DN123 1
#endif
  for (int rp_ = 0; rp_ < PROBE_DN123; ++rp_) {
  if (tid < 384) {
    const int cq = tid % 96, tg = tid / 96;
    const int part = cq >> 5, within = (cq & 31) * 4;
    const int wcol = part * 1024 + h * 128 + within;
    float w[4][4];
#pragma unroll
    for (int k = 0; k < 4; ++k)
#pragma unroll
      for (int c = 0; c < 4; ++c) w[k][c] = p.dn_conv_w[k * 3072 + wcol + c];
    float win[3][4];
    const int pos0 = n * 64 + tg * 16;
#pragma unroll
    for (int i = 0; i < 3; ++i) {
      const int pos = pos0 - 3 + i;
      if (pos >= 0) { const u32x2 r = *(const u32x2*)(proj + ((size_t)b * SEQ + pos) * PROJ_N + 3072 + wcol); win[i][0] = bflo(r.x); win[i][1] = bfhi(r.x); win[i][2] = bflo(r.y); win[i][3] = bfhi(r.y); }
      else { win[i][0] = win[i][1] = win[i][2] = win[i][3] = 0.f; }
    }
    float* dstbase = (part == 0 ? qs : part == 1 ? ks : vs) + within;
#pragma unroll
    for (int i = 0; i < 16; ++i) {
      const u32x2 r = *(const u32x2*)(proj + ((size_t)b * SEQ + pos0 + i) * PROJ_N + 3072 + wcol);
      float cur[4] = {bflo(r.x), bfhi(r.x), bflo(r.y), bfhi(r.y)};
      f32x4 o;
#pragma unroll
      for (int c = 0; c < 4; ++c) { const float a = w[0][c] * win[0][c] + w[1][c] * win[1][c] + w[2][c] * win[2][c] + w[3][c] * cur[c]; o[c] = siluf_(a); win[0][c] = win[1][c]; win[1][c] = win[2][c]; win[2][c] = cur[c]; }
      *(f32x4*)(dstbase + (tg * 16 + i) * QS_LD) = o;
    }
  } else if (wave == 7) {
    const float bl = ext[(tok0 + lane) * 16 + h], al = ext[(tok0 + lane) * 16 + 8 + h];
    float g = -__expf(p.dn_a_log[h]) * softplusf_(al + p.dn_dt_bias[h]);
#pragma unroll
    for (int o = 1; o < 64; o <<= 1) { const float t = __shfl_up(g, o); if (lane >= o) g += t; }
    gcs[lane] = g; betas[lane] = sigmoidf_(bl);
    if (lane == 63) GL[chunk] = g;
  }
  __syncthreads();
  {
    const int row = tid >> 2, part = tid & 3;
    float* base = (row < 64 ? qs + row * QS_LD : ks + (row - 64) * QS_LD) + part * 32;
    f32x4 v[8]; float ss = 0.f;
#pragma unroll
    for (int i = 0; i < 8; ++i) { v[i] = *(const f32x4*)(base + 4 * i); ss += v[i][0] * v[i][0] + v[i][1] * v[i][1] + v[i][2] * v[i][2] + v[i][3] * v[i][3]; }
    ss += __shfl_xor(ss, 1); ss += __shfl_xor(ss, 2);
    float rs = rsqrtf(ss + EPS); if (row < 64) rs *= 0.08838834764831845f;
#pragma unroll
    for (int i = 0; i < 8; ++i) *(f32x4*)(base + 4 * i) = v[i] * rs;
  }
  __syncthreads();
  {
    const int sel = wave >> 2, mb = wave & 3, r = lane & 15, quad = lane >> 4;
    const float* X = sel ? qs : ks;
    bf16x8 af[4];
#pragma unroll
    for (int kk = 0; kk < 4; ++kk) {
      const f32x4 a0 = *(const f32x4*)(X + (16 * mb + r) * QS_LD + 32 * kk + 8 * quad), a1 = *(const f32x4*)(X + (16 * mb + r) * QS_LD + 32 * kk + 8 * quad + 4);
      u32x4 t; t[0] = pk_bf16(a0[0], a0[1]); t[1] = pk_bf16(a0[2], a0[3]); t[2] = pk_bf16(a1[0], a1[1]); t[3] = pk_bf16(a1[2], a1[3]);
      af[kk] = __builtin_bit_cast(bf16x8, t);
    }
    for (int nb = 0; nb < 4; ++nb) {
      f32x4 d = {0.f, 0.f, 0.f, 0.f};
      if (nb <= mb) {
#pragma unroll
        for (int kk = 0; kk < 4; ++kk) {
          const f32x4 b0 = *(const f32x4*)(ks + (16 * nb + r) * QS_LD + 32 * kk + 8 * quad), b1 = *(const f32x4*)(ks + (16 * nb + r) * QS_LD + 32 * kk + 8 * quad + 4);
          u32x4 t; t[0] = pk_bf16(b0[0], b0[1]); t[1] = pk_bf16(b0[2], b0[3]); t[2] = pk_bf16(b1[0], b1[1]); t[3] = pk_bf16(b1[2], b1[3]);
          d = __builtin_amdgcn_mfma_f32_16x16x32_bf16(af[kk], __builtin_bit_cast(bf16x8, t), d, 0, 0, 0);
        }
      }
      const int j = 16 * nb + r; const float gj = gcs[j];
#pragma unroll
      for (int reg = 0; reg < 4; ++reg) {
        const int i = 16 * mb + 4 * quad + reg;
        float val = 0.f;
        if (sel == 0) { if (j < i) val = d[reg] * __expf(gcs[i] - gj) * betas[i]; Lm[j * LM_LD + i] = val; }
        else { if (j <= i) val = d[reg] * __expf(gcs[i] - gj); QAg[(size_t)chunk * 4096 + i * 64 + permcol(j)] = (bf16_t)(pk_bf16(val, 0.f) & 0xffff); }
      }
    }
    { const int row = tid >> 3, c0 = (tid & 7) * 16; const float e = __expf(gcs[row]);
#pragma unroll
      for (int i = 0; i < 4; ++i) { const f32x4 v = *(const f32x4*)(qs + row * QS_LD + c0 + 4 * i) * e; u32x2 o; o.x = pk_bf16(v[0], v[1]); o.y = pk_bf16(v[2], v[3]);
        *(u32x2*)(QDg + (size_t)chunk * 8192 + row * 128 + permcol(c0 + 4 * i)) = o; } }
    { const int d = tid >> 2, t0 = (tid & 3) * 16; const float gl = gcs[63];
#pragma unroll
      for (int i = 0; i < 4; ++i) { float a[4];
#pragma unroll
        for (int e = 0; e < 4; ++e) a[e] = ks[(t0 + 4 * i + e) * QS_LD + d] * __expf(gl - gcs[t0 + 4 * i + e]);
        u32x2 o; o.x = pk_bf16(a[0], a[1]); o.y = pk_bf16(a[2], a[3]);
        *(u32x2*)(KTg + (size_t)chunk * 8192 + d * 64 + permcol(t0 + 4 * i)) = o; } }
  }
  __syncthreads();
  }
  if (tid < 256) {
    const int c = tid & 127; const bool isw = tid >= 128;
    float* src = (isw ? ks : vs) + c;
    bf16_t* dst = isw ? Wg + (size_t)chunk * 8192 + permcol(c) : Ug + (size_t)chunk * 8192 + c * 64;
#pragma unroll 1
    for (int ib = 0; ib < 4; ++ib) {
      float rr[16];
#pragma unroll
      for (int ii = 0; ii < 16; ++ii) { const int i = 16 * ib + ii; float v = src[i * QS_LD] * betas[i]; if (isw) v *= __expf(gcs[i]); rr[ii] = v; }
#pragma unroll 2
      for (int j = 0; j < 16 * ib; ++j) {
        const float xj = src[j * QS_LD];
        const f32x4* lp = (const f32x4*)(Lm + j * LM_LD + 16 * ib);
#pragma unroll
        for (int q = 0; q < 4; ++q) { const f32x4 l = lp[q];
#pragma unroll
          for (int e = 0; e < 4; ++e) rr[4 * q + e] -= l[e] * xj; }
      }
#pragma unroll
      for (int jj = 0; jj < 16; ++jj) {
        const float xj = rr[jj];
        src[(16 * ib + jj) * QS_LD] = xj;
        if (isw) dst[(16 * ib + jj) * 128] = (bf16_t)(pk_bf16(xj, 0.f) & 0xffff);
        else if ((jj & 3) == 3) { u32x2 o; o.x = pk_bf16(rr[jj - 3], rr[jj - 2]); o.y = pk_bf16(rr[jj - 1], xj); *(u32x2*)(dst + 16 * ib + jj - 3) = o; }
        const f32x4* lp = (const f32x4*)(Lm + (16 * ib + jj) * LM_LD + 16 * ib);
#pragma unroll
        for (int q = (jj + 1) / 4; q < 4; ++q) { const f32x4 l = lp[q];
#pragma unroll
          for (int e = 0; e < 4; ++e) if (4 * q + e > jj) rr[4 * q + e] -= l[e] * xj; }
      }
    }
  }
  __syncthreads();
}

typedef short s16x4 __attribute__((ext_vector_type(4)));
constexpr int WL_BYTES = 20480, TL_LD = 68;
DI int img_off(int row, int c32) { return row * 256 + ((c32 ^ (row & 7)) << 5); }
DI s16x4 tr_read1(unsigned a0);
DI bf16x8 tr_read2(unsigned a0, unsigned a1) {
  const s16x4 lo = tr_read1(a0), hi = tr_read1(a1);
  return __builtin_shufflevector(lo, hi, 0, 1, 2, 3, 4, 5, 6, 7);
}
DI void tr_read4(unsigned a0, unsigned a1, unsigned a2, unsigned a3, s16x4& r0, s16x4& r1, s16x4& r2, s16x4& r3) {
  asm volatile("ds_read_b64_tr_b16 %0, %4\n\tds_read_b64_tr_b16 %1, %5\n\tds_read_b64_tr_b16 %2, %6\n\tds_read_b64_tr_b16 %3, %7\n\ts_waitcnt lgkmcnt(0)"
               : "=&v"(r0), "=&v"(r1), "=&v"(r2), "=&v"(r3) : "v"(a0), "v"(a1), "v"(a2), "v"(a3) : "memory");
}
DI s16x4 tr_read1(unsigned a0) { s16x4 lo; asm volatile("ds_read_b64_tr_b16 %0, %1\n\ts_waitcnt lgkmcnt(0)" : "=&v"(lo) : "v"(a0) : "memory"); return lo; }
#ifndef DBG_NOSOLVE
#define DBG_NOSOLVE 0
#endif
#ifndef DNW_OUT
#define DNW_OUT 63
#endif
DI void dn_chunk_wave(const Params& p, int chunk_, char* smem_) {
  const int TIDX = launder_tid();
  const int chunk = __builtin_amdgcn_readfirstlane(chunk_);
  char* wl = smem_ + __builtin_amdgcn_readfirstlane(TIDX >> 6) * WL_BYTES;
  char* ws = p.ws;
  const bf16_t* proj = (const bf16_t*)(ws + OFF_PROJ);
  const float* ext = (const float*)(ws + OFF_EXT);
  bf16_t* Ug = (bf16_t*)p.out;
  bf16_t* Wg = Ug + (size_t)NCHUNK * 8192; bf16_t* QDg = Wg + (size_t)NCHUNK * 8192; bf16_t* KTg = QDg + (size_t)NCHUNK * 8192;
  bf16_t* QAg = (bf16_t*)(ws + OFF_QA);
  float* GL = (float*)(ws + OFF_GL);
  float* T = (float*)wl;
  const unsigned wl_addr = (unsigned)(size_t)wl;
  int lane = TIDX & 63;
#define r (lane & 15)
#define quad (lane >> 4)
#define RELAUNDER() asm volatile("" : "+v"(lane))
  const int bh = chunk >> 6, n = chunk & 63, b = bh >> 3, h = bh & 7;
  const size_t tok0 = (size_t)b * SEQ + n * 64;
  float gcl, betal;
  {
    const float bl = ext[(tok0 + lane) * 16 + h], al = ext[(tok0 + lane) * 16 + 8 + h];
    float g = -__expf(p.dn_a_log[h]) * softplusf_(al + p.dn_dt_bias[h]);
#pragma unroll
    for (int o = 1; o < 64; o <<= 1) { const float t = __shfl_up(g, o); if (lane >= o) g += t; }
    gcl = g; betal = sigmoidf_(bl);
    if ((DNW_OUT & 32) && lane == 63) GL[chunk] = g;
  }
  auto load_w = [&](int part, int kk, f32x4 (&wt)[4][2]) {
    const int col = part * 1024 + h * 128 + 32 * kk + 8 * quad;
#pragma unroll
    for (int tap = 0; tap < 4; ++tap) { const unsigned o = (unsigned)(tap * 3072 + col) * 4u; wt[tap][0] = *(const f32x4*)((const char*)p.dn_conv_w + o); wt[tap][1] = *(const f32x4*)((const char*)p.dn_conv_w + o + 16u); }
  };
  auto conv_frag = [&](int part, int mb, int kk, const f32x4 (&wt)[4][2], float (&out)[8]) {
    const int col = part * 1024 + h * 128 + 32 * kk + 8 * quad;
    float a[8];
#pragma unroll
    for (int c = 0; c < 8; ++c) a[c] = 0.f;
#pragma unroll
    for (int tap = 0; tap < 4; ++tap) {
      const int pos = n * 64 + 16 * mb + r - 3 + tap;
      u32x4 raw = {0u, 0u, 0u, 0u};
      if (pos >= 0) raw = *(const u32x4*)((const char*)proj + ((unsigned)(b * SEQ + pos) * (unsigned)PROJ_N + 3072u + (unsigned)col) * 2u);
      a[0] += wt[tap][0][0] * bflo(raw[0]); a[1] += wt[tap][0][1] * bfhi(raw[0]); a[2] += wt[tap][0][2] * bflo(raw[1]); a[3] += wt[tap][0][3] * bfhi(raw[1]);
      a[4] += wt[tap][1][0] * bflo(raw[2]); a[5] += wt[tap][1][1] * bfhi(raw[2]); a[6] += wt[tap][1][2] * bflo(raw[3]); a[7] += wt[tap][1][3] * bfhi(raw[3]);
    }
#pragma unroll
    for (int c = 0; c < 8; ++c) out[c] = siluf_(a[c]);
  };
  auto pack8 = [&](const float (&v)[8], float sc) -> bf16x8 {
    u32x4 t; t[0] = pk_bf16(v[0] * sc, v[1] * sc); t[1] = pk_bf16(v[2] * sc, v[3] * sc); t[2] = pk_bf16(v[4] * sc, v[5] * sc); t[3] = pk_bf16(v[6] * sc, v[7] * sc);
    return __builtin_bit_cast(bf16x8, t);
  };
  auto scale8 = [&](bf16x8 f, float sc) -> u32x4 {
    const u32x4 t = __builtin_bit_cast(u32x4, f); u32x4 o;
#pragma unroll
    for (int i = 0; i < 4; ++i) o[i] = pk_bf16(bflo(t[i]) * sc, bfhi(t[i]) * sc);
    return o;
  };
  bf16x8 kfrag[4][4];
  float rskl;
  {
    float ss[4] = {0.f, 0.f, 0.f, 0.f};
#pragma unroll
    for (int kk = 0; kk < 4; ++kk) {
      f32x4 wt[4][2]; load_w(1, kk, wt);
#pragma unroll
      for (int mb = 0; mb < 4; ++mb) { float f[8]; conv_frag(1, mb, kk, wt, f); kfrag[mb][kk] = pack8(f, 1.f);
#pragma unroll
        for (int c = 0; c < 8; ++c) ss[mb] += f[c] * f[c];
        if (mb == 3) { asm volatile("" ::: "memory"); __builtin_amdgcn_sched_barrier(0); } }
    }
#pragma unroll
    for (int mb = 0; mb < 4; ++mb) { float t = ss[mb]; t += __shfl_xor(t, 16); t += __shfl_xor(t, 32); ss[mb] = rsqrtf(t + EPS); }
    rskl = quad == 0 ? ss[0] : quad == 1 ? ss[1] : quad == 2 ? ss[2] : ss[3];
  }
#ifndef DNW_STOP
#define DNW_STOP 99
#endif
  if (DNW_STOP == 1) { if (kfrag[0][0][0] == 12345 && kfrag[3][3][1] == 7 && kfrag[1][2][3] == 5 && kfrag[2][1][0] == 9) GL[0] = 1.f; return; }
  RELAUNDER();
  const float glast = __shfl(gcl, 63);
  float gcr[4], betar[4], rskr[4];
#pragma unroll
  for (int mb = 0; mb < 4; ++mb) { gcr[mb] = __shfl(gcl, 16 * mb + r); betar[mb] = __shfl(betal, 16 * mb + r); rskr[mb] = __shfl(rskl, 16 * mb + r); }
#pragma unroll
  for (int mb = 0; mb < 4; ++mb) {
    float gci[4], bi[4];
#pragma unroll
    for (int reg = 0; reg < 4; ++reg) { gci[reg] = __shfl(gcl, 16 * mb + 4 * quad + reg); bi[reg] = __shfl(betal, 16 * mb + 4 * quad + reg) * __shfl(rskl, 16 * mb + 4 * quad + reg); }
#pragma unroll
    for (int nb = 0; nb < 4; ++nb) {
      f32x4 dl = {0.f, 0.f, 0.f, 0.f};
      if (nb <= mb) {
#pragma unroll
        for (int kk = 0; kk < 4; ++kk) dl = __builtin_amdgcn_mfma_f32_16x16x32_bf16(kfrag[mb][kk], kfrag[nb][kk], dl, 0, 0, 0);
      }
      const int j = 16 * nb + r; const float gj = gcr[nb], rj = rskr[nb];
      f32x4 lv;
#pragma unroll
      for (int reg = 0; reg < 4; ++reg) { const int i = 16 * mb + 4 * quad + reg; lv[reg] = (nb <= mb && j < i) ? dl[reg] * __expf(fminf(gci[reg] - gj, 0.f)) * (bi[reg] * rj) : 0.f; }
      *(f32x4*)(T + j * TL_LD + 16 * mb + 4 * quad) = lv;
      __builtin_amdgcn_sched_barrier(0);
    }
  }
  RELAUNDER();
#pragma unroll 1
  for (int mb = 0; mb < 4; ++mb) {
    bf16x8 qf[4];
    float rsq;
    {
      float ss = 0.f;
#pragma unroll
      for (int kk = 0; kk < 4; ++kk) { f32x4 wt[4][2]; load_w(0, kk, wt); float f[8]; conv_frag(0, mb, kk, wt, f); qf[kk] = pack8(f, 1.f);
#pragma unroll
        for (int c = 0; c < 8; ++c) ss += f[c] * f[c];
        if (kk == 3) { asm volatile("" ::: "memory"); __builtin_amdgcn_sched_barrier(0); } }
      ss += __shfl_xor(ss, 16); ss += __shfl_xor(ss, 32);
      rsq = rsqrtf(ss + EPS) * 0.08838834764831845f;
    }
    {
      const float sq = __expf(__shfl(gcl, 16 * mb + r)) * rsq;
      bf16_t* dq = QDg + (size_t)chunk * 8192 + (16 * mb + r) * 128;
#pragma unroll
      for (int kk = 0; kk < 4; ++kk) { const u32x4 qd = scale8(qf[kk], sq);
        if (DNW_OUT & 4) { *(u32x2*)(dq + permcol(32 * kk + 8 * quad)) = (u32x2){qd[0], qd[1]}; *(u32x2*)(dq + permcol(32 * kk + 8 * quad + 4)) = (u32x2){qd[2], qd[3]}; } }
    }
    float gci[4], rqi[4];
#pragma unroll
    for (int reg = 0; reg < 4; ++reg) { gci[reg] = __shfl(gcl, 16 * mb + 4 * quad + reg); rqi[reg] = __shfl(rsq, 4 * quad + reg); }
    bf16_t* qrow = QAg + (size_t)chunk * 4096 + (16 * mb + 4 * quad) * 64;
#pragma unroll
    for (int nb = 0; nb < 4; ++nb) {
      f32x4 dq = {0.f, 0.f, 0.f, 0.f};
#pragma unroll
      for (int kk = 0; kk < 4; ++kk) dq = __builtin_amdgcn_mfma_f32_16x16x32_bf16(qf[kk], kfrag[nb][kk], dq, 0, 0, 0);
      const int j = 16 * nb + r; const float gj = gcr[nb], rj = rskr[nb];
#pragma unroll
      for (int reg = 0; reg < 4; ++reg) {
        const int i = 16 * mb + 4 * quad + reg;
        const float qv = (j <= i) ? dq[reg] * __expf(fminf(gci[reg] - gj, 0.f)) * (rqi[reg] * rj) : 0.f;
        if (DNW_OUT & 16) qrow[reg * 64 + permcol(j)] = (bf16_t)(pk_bf16(qv, 0.f) & 0xffff);
      }
    }
  }
  wave_lds_sync();
  if (DNW_STOP == 2) { if (kfrag[0][0][0] == 12345) GL[0] = 1.f; return; }
  RELAUNDER();
  {
    const int c = lane;
#pragma unroll 1
    for (int ib = 0; ib < (DBG_NOSOLVE ? 0 : 4); ++ib) {
      float rr[16];
#pragma unroll
      for (int ii = 0; ii < 16; ++ii) rr[ii] = (16 * ib + ii == c) ? 1.f : 0.f;
#pragma unroll 2
      for (int j = 0; j < 16 * ib; ++j) {
        const float xj = T[c * TL_LD + j];
        const f32x4* lp = (const f32x4*)(T + j * TL_LD + 16 * ib);
#pragma unroll
        for (int q = 0; q < 4; ++q) { const f32x4 l = lp[q];
#pragma unroll
          for (int e = 0; e < 4; ++e) rr[4 * q + e] -= l[e] * xj; }
      }
#pragma unroll
      for (int jj = 0; jj < 16; ++jj) {
        const float xj = rr[jj];
        const f32x4* lp = (const f32x4*)(T + (16 * ib + jj) * TL_LD + 16 * ib);
#pragma unroll
        for (int q = (jj + 1) / 4; q < 4; ++q) { const f32x4 l = lp[q];
#pragma unroll
          for (int e = 0; e < 4; ++e) if (4 * q + e > jj) rr[4 * q + e] -= l[e] * xj; }
      }
      wave_lds_sync();
#pragma unroll
      for (int q = 0; q < 4; ++q) *(f32x4*)(T + c * TL_LD + 16 * ib + 4 * q) = (f32x4){rr[4 * q], rr[4 * q + 1], rr[4 * q + 2], rr[4 * q + 3]};
      wave_lds_sync();
    }
  }
  if (DNW_STOP == 3) { if (kfrag[0][0][0] == 12345) GL[0] = 1.f; return; }
  RELAUNDER();
  bf16x8 tfrag[4][2];
#pragma unroll
  for (int mb = 0; mb < 4; ++mb)
#pragma unroll
    for (int k2 = 0; k2 < 2; ++k2) {
      float v[8];
#pragma unroll
      for (int jj = 0; jj < 8; ++jj) v[jj] = T[(32 * k2 + 8 * quad + jj) * TL_LD + 16 * mb + r];
      tfrag[mb][k2] = pack8(v, 1.f);
      __builtin_amdgcn_sched_barrier(0);
    }
  wave_lds_sync();
#define i16q ((lane & 15) >> 2)
#define i16p (lane & 3)
  RELAUNDER();
#pragma unroll 1
  for (int kk = 0; kk < 4; ++kk) {
    f32x4 wt[4][2]; load_w(2, kk, wt);
#pragma unroll 4
    for (int mb = 0; mb < 4; ++mb) { float f[8]; conv_frag(2, mb, kk, wt, f);
      *(bf16x8*)(wl + img_off(16 * mb + r, 2 * kk + (quad >> 1)) + 16 * (quad & 1)) = pack8(f, __shfl(betal, 16 * mb + r)); }
  }
  wave_lds_sync();
#pragma unroll 1
  for (int cb = 0; cb < 8; ++cb) {
    bf16x8 bf[2];
    { const int t0 = 8 * quad + i16q; s16x4 x0, x1, x2, x3;
      tr_read4(wl_addr + img_off(t0, cb) + 8 * i16p, wl_addr + img_off(t0 + 4, cb) + 8 * i16p, wl_addr + img_off(t0 + 32, cb) + 8 * i16p, wl_addr + img_off(t0 + 36, cb) + 8 * i16p, x0, x1, x2, x3);
      bf[0] = __builtin_shufflevector(x0, x1, 0, 1, 2, 3, 4, 5, 6, 7); bf[1] = __builtin_shufflevector(x2, x3, 0, 1, 2, 3, 4, 5, 6, 7); }
#pragma unroll
    for (int mb = 0; mb < 4; ++mb) {
      f32x4 d = {0.f, 0.f, 0.f, 0.f};
#pragma unroll
      for (int k2 = 0; k2 < 2; ++k2) d = __builtin_amdgcn_mfma_f32_16x16x32_bf16(tfrag[mb][k2], bf[k2], d, 0, 0, 0);
      u32x2 o; o.x = pk_bf16_mfma(d[0], d[1]); o.y = pk_bf16_mfma(d[2], d[3]);
      if (DNW_OUT & 1) *(u32x2*)(Ug + (size_t)chunk * 8192 + (16 * cb + r) * 64 + 16 * mb + 4 * quad) = o;
    }
  }
  wave_lds_sync();
  if (DNW_STOP == 4) { if (kfrag[0][0][0] == 12345) GL[0] = 1.f; return; }
  RELAUNDER();
#pragma unroll
  for (int mb = 0; mb < 4; ++mb) { const float sc = betar[mb] * __expf(gcr[mb]) * rskr[mb];
#pragma unroll
    for (int kk = 0; kk < 4; ++kk) *(u32x4*)(wl + img_off(16 * mb + r, 2 * kk + (quad >> 1)) + 16 * (quad & 1)) = scale8(kfrag[mb][kk], sc);
    __builtin_amdgcn_sched_barrier(0); }
  wave_lds_sync();
#pragma unroll 1
  for (int cb = 0; cb < 8; ++cb) {
    bf16x8 af[2];
    { const int t0 = 8 * quad + i16q; s16x4 x0, x1, x2, x3;
      tr_read4(wl_addr + img_off(t0, cb) + 8 * i16p, wl_addr + img_off(t0 + 4, cb) + 8 * i16p, wl_addr + img_off(t0 + 32, cb) + 8 * i16p, wl_addr + img_off(t0 + 36, cb) + 8 * i16p, x0, x1, x2, x3);
      af[0] = __builtin_shufflevector(x0, x1, 0, 1, 2, 3, 4, 5, 6, 7); af[1] = __builtin_shufflevector(x2, x3, 0, 1, 2, 3, 4, 5, 6, 7); }
#pragma unroll
    for (int mb = 0; mb < 4; ++mb) {
      f32x4 d = {0.f, 0.f, 0.f, 0.f};
#pragma unroll
      for (int k2 = 0; k2 < 2; ++k2) d = __builtin_amdgcn_mfma_f32_16x16x32_bf16(af[k2], tfrag[mb][k2], d, 0, 0, 0);
      u32x2 o; o.x = pk_bf16_mfma(d[0], d[1]); o.y = pk_bf16_mfma(d[2], d[3]);
      if (DNW_OUT & 2) *(u32x2*)(Wg + (size_t)chunk * 8192 + (16 * mb + r) * 128 + permcol(16 * cb + 4 * quad)) = o;
    }
  }
  wave_lds_sync();
  RELAUNDER();
#pragma unroll
  for (int mb = 0; mb < 4; ++mb) { const float sk = __expf(glast - gcr[mb]) * rskr[mb];
#pragma unroll
    for (int kk = 0; kk < 4; ++kk) *(u32x4*)(wl + img_off(16 * mb + r, 2 * kk + (quad >> 1)) + 16 * (quad & 1)) = scale8(kfrag[mb][kk], sk);
    __builtin_amdgcn_sched_barrier(0); }
  wave_lds_sync();
#pragma unroll 1
  for (int cb = 0; cb < 8; ++cb)
    {
      s16x4 v0, v1, v2, v3; const int t0 = 4 * quad + i16q;
      tr_read4(wl_addr + img_off(t0, cb) + 8 * i16p, wl_addr + img_off(t0 + 16, cb) + 8 * i16p, wl_addr + img_off(t0 + 32, cb) + 8 * i16p, wl_addr + img_off(t0 + 48, cb) + 8 * i16p, v0, v1, v2, v3);
      bf16_t* kt = KTg + (size_t)chunk * 8192 + (16 * cb + r) * 64;
      if (DNW_OUT & 8) { *(s16x4*)(kt + permcol(4 * quad)) = v0; *(s16x4*)(kt + permcol(16 + 4 * quad)) = v1; *(s16x4*)(kt + permcol(32 + 4 * quad)) = v2; *(s16x4*)(kt + permcol(48 + 4 * quad)) = v3; }
    }
  wave_lds_sync();
}
#undef r
#undef quad
#undef RELAUNDER
#undef i16q
#undef i16p

constexpr int VS_LD = 136;
DI void sb_unit(const Params& p, int unit, bf16_t* vl) {
  const int TIDX = launder_tid();
  char* ws = p.ws;
  const bf16_t* proj = (const bf16_t*)(ws + OFF_PROJ);
  bf16_t* mix = (bf16_t*)(ws + OFF_A);
  const int lane = TIDX & 63, r = lane & 31, hh = lane >> 5;
  const int b = unit >> 10, h = (unit >> 7) & 7, qb = unit & 127;
  const size_t rowbase = (size_t)b * SEQ;
  const int t0 = qb * 32;
  bf16x8 qf[8];
#pragma unroll
  for (int kk = 0; kk < 8; ++kk) qf[kk] = *(const bf16x8*)(proj + (rowbase + t0 + r) * PROJ_N + h * 128 + 16 * kk + 8 * hh);
  bf16x8 uf[2];
#pragma unroll
  for (int st = 0; st < 2; ++st)
#pragma unroll
    for (int j = 0; j < 8; ++j) { const int key = 16 * st + 8 * (j >> 2) + 4 * hh + (j & 3); uf[st][j] = (short)(key >= r ? 0x3F80 : 0); }
  float carry = 0.f;
  f32x16 o[4];
#pragma unroll
  for (int db = 0; db < 4; ++db)
#pragma unroll
    for (int i = 0; i < 16; ++i) o[db][i] = 0.f;
  const float scale = 0.08838834764831845f;
  for (int kb = qb; kb >= 0; --kb) {
    const int s0 = kb * 32;
#pragma unroll
    for (int i = 0; i < 8; ++i) { const int idx = lane + 64 * i, key = idx >> 4, c16 = idx & 15;
      *(u32x4*)(vl + key * VS_LD + c16 * 8) = *(const u32x4*)(proj + (rowbase + s0 + key) * PROJ_N + 2048 + h * 128 + c16 * 8); }
    f32x16 z;
#pragma unroll
    for (int i = 0; i < 16; ++i) z[i] = 0.f;
#pragma unroll
    for (int kk = 0; kk < 8; ++kk) {
      const bf16x8 kf = *(const bf16x8*)(proj + (rowbase + s0 + r) * PROJ_N + 1024 + h * 128 + 16 * kk + 8 * hh);
      z = __builtin_amdgcn_mfma_f32_32x32x16_bf16(kf, qf[kk], z, 0, 0, 0);
    }
    float sp[16]; bool valid[16];
#pragma unroll
    for (int i = 0; i < 16; ++i) {
      const int key = (i & 3) + 8 * (i >> 2) + 4 * hh;
      z[i] *= scale;
      valid[i] = (kb < qb) || (key < r);
      sp[i] = valid[i] ? softplusf_(z[i]) : 0.f;
    }
    f32x16 ct;
#pragma unroll
    for (int i = 0; i < 16; ++i) ct[i] = carry;
#pragma unroll
    for (int st = 0; st < 2; ++st) {
      u32x4 hi, lo;
#pragma unroll
      for (int j2 = 0; j2 < 4; ++j2) {
        const float a = sp[8 * st + 2 * j2], c = sp[8 * st + 2 * j2 + 1];
        const unsigned hp = pk_bf16(a, c);
        hi[j2] = hp; lo[j2] = pk_bf16(a - bflo(hp), c - bfhi(hp));
      }
      ct = __builtin_amdgcn_mfma_f32_32x32x16_bf16(uf[st], __builtin_bit_cast(bf16x8, hi), ct, 0, 0, 0);
      ct = __builtin_amdgcn_mfma_f32_32x32x16_bf16(uf[st], __builtin_bit_cast(bf16x8, lo), ct, 0, 0, 0);
    }
    bf16x8 pa[2];
#pragma unroll
    for (int st = 0; st < 2; ++st) {
      u32x4 t;
#pragma unroll
      for (int j2 = 0; j2 < 4; ++j2) {
        const int i0 = 8 * st + 2 * j2;
        const float a = valid[i0] ? __expf(z[i0] - ct[i0]) : 0.f, c = valid[i0 + 1] ? __expf(z[i0 + 1] - ct[i0 + 1]) : 0.f;
        t[j2] = pk_bf16(a, c);
      }
      pa[st] = __builtin_bit_cast(bf16x8, t);
    }
    carry = __shfl(ct[0], r);
    wave_lds_sync();
#pragma unroll
    for (int db = 0; db < 4; ++db)
#pragma unroll
      for (int st = 0; st < 2; ++st) {
        bf16x8 vf;
#pragma unroll
        for (int j = 0; j < 8; ++j) { const int key = 16 * st + 8 * (j >> 2) + 4 * hh + (j & 3); vf[j] = (short)vl[key * VS_LD + 32 * db + r]; }
        o[db] = __builtin_amdgcn_mfma_f32_32x32x16_bf16(vf, pa[st], o[db], 0, 0, 0);
      }
    wave_lds_sync();
    if (__all(carry > 104.f)) break;
  }
  float ss = 0.f;
#pragma unroll
  for (int db = 0; db < 4; ++db)
#pragma unroll
    for (int i = 0; i < 16; ++i) ss += o[db][i] * o[db][i];
  ss += __shfl_xor(ss, 32);
  const float rs = rsqrtf(ss * (1.f / 128.f) + EPS);
#pragma unroll
  for (int db = 0; db < 4; ++db)
#pragma unroll
    for (int g4 = 0; g4 < 4; ++g4) {
      const int d = 32 * db + 8 * g4 + 4 * hh;
      const f32x4 gn = *(const f32x4*)(p.sb_gain + d);
      u32x2 v; v.x = pk_bf16(o[db][4 * g4] * rs * gn[0], o[db][4 * g4 + 1] * rs * gn[1]); v.y = pk_bf16(o[db][4 * g4 + 2] * rs * gn[2], o[db][4 * g4 + 3] * rs * gn[3]);
      *(u32x2*)(vl + r * VS_LD + d) = v;
    }
  wave_lds_sync();
#pragma unroll
  for (int i = 0; i < 8; ++i) { const int idx = lane + 64 * i, q = idx >> 4, c16 = idx & 15;
    *(u32x4*)(mix + (rowbase + t0 + q) * D_MODEL + h * 128 + c16 * 8) = *(const u32x4*)(vl + q * VS_LD + c16 * 8); }
  wave_lds_sync();
}

DI bf16x8 pack_rows(const f32x4& a, const f32x4& b) { u32x4 t; t[0] = pk_bf16_mfma(a[0], a[1]); t[1] = pk_bf16_mfma(a[2], a[3]); t[2] = pk_bf16_mfma(b[0], b[1]); t[3] = pk_bf16_mfma(b[2], b[3]); return __builtin_bit_cast(bf16x8, t); }
constexpr int SC_W = 0, SC_QD = 16384, SC_KT = 32768, SC_QA = 49152, SC_U = 57344, SC_BUF = 65536;
DI int swz256(int row, int ch) { return row * 256 + ((ch ^ (row & 15)) << 4); }
DI int swz128(int row, int ch) { return row * 128 + ((ch ^ ((row >> 1) & 7)) << 4); }
DI void dn_scan_block(const Params& p, int unit, char* smem) {
  const int TIDX = launder_tid();
  char* ws = p.ws;
  const bf16_t* Ug = (const bf16_t*)p.out;
  const bf16_t* Wg = Ug + (size_t)NCHUNK * 8192; const bf16_t* QDg = Wg + (size_t)NCHUNK * 8192; const bf16_t* KTg = QDg + (size_t)NCHUNK * 8192;
  const bf16_t* QAg = (const bf16_t*)(ws + OFF_QA);
  const float* GL = (const float*)(ws + OFF_GL);
  float* odn = (float*)(ws + OFF_ODN);
  const int bh = unit >> 1, half = unit & 1, b = bh >> 3, h = bh & 7;
  const int wave = TIDX >> 6, lane = TIDX & 63, r = lane & 15, quad = lane >> 4;
  const int e0 = half * 64 + wave * 16;
  const int lt = TIDX & 255;
#define SC_OFF(i) ((i) < 4 ? SC_W + swz256((lt + 256 * (i)) >> 4, (lt + 256 * (i)) & 15) : (i) < 8 ? SC_QD + swz256((lt + 256 * ((i) - 4)) >> 4, (lt + 256 * ((i) - 4)) & 15) : \
                    (i) < 12 ? SC_KT + swz128((lt + 256 * ((i) - 8)) >> 3, (lt + 256 * ((i) - 8)) & 7) : (i) < 14 ? SC_QA + swz128((lt + 256 * ((i) - 12)) >> 3, (lt + 256 * ((i) - 12)) & 7) : \
                    SC_U + swz128((lt + 256 * ((i) - 14)) >> 3, (lt + 256 * ((i) - 14)) & 7))
#define SC_SRC(i, c_) ((i) < 4 ? Wg + (c_) * 8192 + (lt + 256 * (i)) * 8 : (i) < 8 ? QDg + (c_) * 8192 + (lt + 256 * ((i) - 4)) * 8 : (i) < 12 ? KTg + (c_) * 8192 + (lt + 256 * ((i) - 8)) * 8 : \
                       (i) < 14 ? QAg + (c_) * 4096 + (lt + 256 * ((i) - 12)) * 8 : Ug + (c_) * 8192 + half * 4096 + (lt + 256 * ((i) - 14)) * 8)
#define SC_LOAD(st, chunk) do { const size_t c_ = (chunk); _Pragma("unroll") for (int i_ = 0; i_ < 16; ++i_) st[i_] = __builtin_nontemporal_load((const u32x4*)(SC_SRC(i_, c_))); } while (0)
#define SC_STORE(st, buf) do { char* b_ = smem + (buf) * SC_BUF; _Pragma("unroll") for (int i_ = 0; i_ < 16; ++i_) *(u32x4*)(b_ + SC_OFF(i_)) = st[i_]; } while (0)
  f32x4 S[8];
#pragma unroll
  for (int i = 0; i < 8; ++i) S[i] = (f32x4){0.f, 0.f, 0.f, 0.f};
  const size_t chunk0 = (size_t)bh * 64;
  const float eglv = __expf(GL[chunk0 + lane]);
  auto compute = [&](int n) {
    if (wave < 4) {
      const char* B = smem + (n & 1) * SC_BUF;
      bf16x8 Sb[4];
#pragma unroll
      for (int kk = 0; kk < 4; ++kk) Sb[kk] = pack_rows(S[2 * kk], S[2 * kk + 1]);
      f32x4 vn[4];
#pragma unroll
      for (int tb = 0; tb < 4; ++tb) {
        f32x4 acc = {0.f, 0.f, 0.f, 0.f};
#pragma unroll
        for (int kk = 0; kk < 4; ++kk) acc = __builtin_amdgcn_mfma_f32_16x16x32_bf16(*(const bf16x8*)(B + SC_W + swz256(16 * tb + r, 4 * kk + quad)), Sb[kk], acc, 0, 0, 0);
        const u32x2 uu = *(const u32x2*)(B + SC_U + swz128(wave * 16 + r, 2 * tb + (quad >> 1)) + (quad & 1) * 8);
        vn[tb][0] = bflo(uu.x) - acc[0]; vn[tb][1] = bfhi(uu.x) - acc[1]; vn[tb][2] = bflo(uu.y) - acc[2]; vn[tb][3] = bfhi(uu.y) - acc[3];
      }
      bf16x8 Vb[2];
      Vb[0] = pack_rows(vn[0], vn[1]); Vb[1] = pack_rows(vn[2], vn[3]);
#pragma unroll
      for (int tb = 0; tb < 4; ++tb) {
        f32x4 acc = {0.f, 0.f, 0.f, 0.f};
#pragma unroll
        for (int kk = 0; kk < 4; ++kk) acc = __builtin_amdgcn_mfma_f32_16x16x32_bf16(*(const bf16x8*)(B + SC_QD + swz256(16 * tb + r, 4 * kk + quad)), Sb[kk], acc, 0, 0, 0);
#pragma unroll
        for (int kt = 0; kt < 2; ++kt) acc = __builtin_amdgcn_mfma_f32_16x16x32_bf16(*(const bf16x8*)(B + SC_QA + swz128(16 * tb + r, 4 * kt + quad)), Vb[kt], acc, 0, 0, 0);
#pragma unroll
        for (int reg = 0; reg < 4; ++reg) odn[((size_t)b * SEQ + n * 64 + 16 * tb + 4 * quad + reg) * 1024 + h * 128 + e0 + r] = acc[reg];
      }
      const float egl = __int_as_float(__builtin_amdgcn_readlane(__float_as_int(eglv), n));
#pragma unroll
      for (int mb = 0; mb < 8; ++mb) {
        f32x4 acc = S[mb] * egl;
#pragma unroll
        for (int kt = 0; kt < 2; ++kt) acc = __builtin_amdgcn_mfma_f32_16x16x32_bf16(*(const bf16x8*)(B + SC_KT + swz128(16 * mb + r, 4 * kt + quad)), Vb[kt], acc, 0, 0, 0);
        S[mb] = acc;
      }
    }
  };
  if (wave >= 4) {
    u32x4 sta[16], stb[16];
    SC_LOAD(sta, chunk0); SC_LOAD(stb, chunk0 + 1); SC_STORE(sta, 0);
    for (int n = 0; n < 64; n += 2) {
      __syncthreads();
      if (n + 2 < 64) SC_LOAD(sta, chunk0 + n + 2);
      SC_STORE(stb, 1);
      __syncthreads();
      if (n + 3 < 64) SC_LOAD(stb, chunk0 + n + 3);
      if (n + 2 < 64) SC_STORE(sta, 0);
    }
  } else {
    for (int n = 0; n < 64; n += 2) {
      __syncthreads();
      compute(n);
      __syncthreads();
      compute(n + 1);
    }
  }
#undef SC_LOAD
#undef SC_STORE
#undef SC_OFF
#undef SC_SRC
}

DI void dn_final_phase(const Params& p) {
  const int TIDX = launder_tid();
  char* ws = p.ws;
  const float* odn = (const float*)(ws + OFF_ODN);
  const bf16_t* proj = (const bf16_t*)(ws + OFF_PROJ);
  bf16_t* mix = (bf16_t*)(ws + OFF_A);
  const int wave = TIDX >> 6, lane = TIDX & 63;
  const int dloc = (lane & 7) * 16;
  f32x4 gn[4];
#pragma unroll
  for (int i = 0; i < 4; ++i) gn[i] = *(const f32x4*)(p.dn_gain + dloc + 4 * i);
  for (int row = blockIdx.x * 8 + wave; row < NTOK; row += gridDim.x * 8) {
    f32x4 v[4]; float ss = 0.f;
#pragma unroll
    for (int i = 0; i < 4; ++i) { v[i] = __builtin_nontemporal_load((const f32x4*)(odn + (size_t)row * 1024 + lane * 16 + 4 * i)); ss += v[i][0] * v[i][0] + v[i][1] * v[i][1] + v[i][2] * v[i][2] + v[i][3] * v[i][3]; }
    ss += __shfl_xor(ss, 1); ss += __shfl_xor(ss, 2); ss += __shfl_xor(ss, 4);
    const float rs = rsqrtf(ss * (1.f / 128.f) + EPS);
    const u32x4 z0 = *(const u32x4*)(proj + (size_t)row * PROJ_N + 6144 + lane * 16), z1 = *(const u32x4*)(proj + (size_t)row * PROJ_N + 6144 + lane * 16 + 8);
    u32x4 o0, o1;
#pragma unroll
    for (int i = 0; i < 4; ++i) {
      const unsigned zz = i < 2 ? z0[2 * i] : z1[2 * (i - 2)], zz2 = i < 2 ? z0[2 * i + 1] : z1[2 * (i - 2) + 1];
      const float a = v[i][0] * rs * gn[i][0] * siluf_(bflo(zz)), c = v[i][1] * rs * gn[i][1] * siluf_(bfhi(zz));
      const float d = v[i][2] * rs * gn[i][2] * siluf_(bflo(zz2)), e = v[i][3] * rs * gn[i][3] * siluf_(bfhi(zz2));
      if (i < 2) { o0[2 * i] = pk_bf16(a, c); o0[2 * i + 1] = pk_bf16(d, e); } else { o1[2 * (i - 2)] = pk_bf16(a, c); o1[2 * (i - 2) + 1] = pk_bf16(d, e); }
    }
    *(u32x4*)(mix + (size_t)row * D_MODEL + 1024 + lane * 16) = o0; *(u32x4*)(mix + (size_t)row * D_MODEL + 1024 + lane * 16 + 8) = o1;
  }
}

DI void rows_mid_phase(const Params& p) {
  const int TIDX = launder_tid();
  char* ws = p.ws;
  const bf16_t* m = (const bf16_t*)(ws + OFF_M);
  bf16_t* hn = (bf16_t*)(ws + OFF_A);
  const int wave = TIDX >> 6, lane = TIDX & 63;
  for (int row = blockIdx.x * 8 + wave; row < NTOK; row += gridDim.x * 8) {
    f32x4 v[8]; float ss = 0.f;
#pragma unroll
    for (int i = 0; i < 8; ++i) { const u32x2 q = __builtin_nontemporal_load((const u32x2*)(m + (size_t)row * D_MODEL + 4 * (lane + 64 * i))); v[i] = (f32x4){bflo(q.x), bfhi(q.x), bflo(q.y), bfhi(q.y)}; ss += v[i][0] * v[i][0] + v[i][1] * v[i][1] + v[i][2] * v[i][2] + v[i][3] * v[i][3]; }
    ss = wave_sum(ss);
    const float rs = rsqrtf(ss * (1.f / D_MODEL) + EPS);
    float s2 = 0.f;
#pragma unroll
    for (int i = 0; i < 8; ++i) {
      const f32x4 g = *(const f32x4*)(p.ln_mix_post + 4 * (lane + 64 * i)), xv = __builtin_nontemporal_load((const f32x4*)(p.x + (size_t)row * D_MODEL + 4 * (lane + 64 * i)));
      v[i] = xv + v[i] * rs * g;
      s2 += v[i][0] * v[i][0] + v[i][1] * v[i][1] + v[i][2] * v[i][2] + v[i][3] * v[i][3];
    }
    s2 = wave_sum(s2);
    const float rs2 = rsqrtf(s2 * (1.f / D_MODEL) + EPS);
#pragma unroll
    for (int i = 0; i < 8; ++i) {
      const f32x4 g = *(const f32x4*)(p.ln_ffn_pre + 4 * (lane + 64 * i));
      const f32x4 y = v[i] * rs2 * g;
      u32x2 o; o.x = pk_bf16(y[0], y[1]); o.y = pk_bf16(y[2], y[3]);
      *(u32x2*)(hn + (size_t)row * D_MODEL + 4 * (lane + 64 * i)) = o;
    }
  }
}
DI void rows_final_phase(const Params& p) {
  const int TIDX = launder_tid();
  char* ws = p.ws;
  const bf16_t* f = (const bf16_t*)(ws + OFF_F);
  const bf16_t* m = (const bf16_t*)(ws + OFF_M);
  const int wave = TIDX >> 6, lane = TIDX & 63;
  for (int row = blockIdx.x * 8 + wave; row < NTOK; row += gridDim.x * 8) {
    f32x4 hv[8]; float s1 = 0.f;
#pragma unroll
    for (int i = 0; i < 8; ++i) { const u32x2 q = __builtin_nontemporal_load((const u32x2*)(m + (size_t)row * D_MODEL + 4 * (lane + 64 * i))); hv[i] = (f32x4){bflo(q.x), bfhi(q.x), bflo(q.y), bfhi(q.y)}; s1 += hv[i][0] * hv[i][0] + hv[i][1] * hv[i][1] + hv[i][2] * hv[i][2] + hv[i][3] * hv[i][3]; }
    s1 = wave_sum(s1);
    const float rs1 = rsqrtf(s1 * (1.f / D_MODEL) + EPS);
#pragma unroll
    for (int i = 0; i < 8; ++i) {
      const f32x4 g = *(const f32x4*)(p.ln_mix_post + 4 * (lane + 64 * i)), xv = __builtin_nontemporal_load((const f32x4*)(p.x + (size_t)row * D_MODEL + 4 * (lane + 64 * i)));
      hv[i] = xv + hv[i] * rs1 * g;
    }
    f32x4 v[8]; float ss = 0.f;
#pragma unroll
    for (int i = 0; i < 8; ++i) { const u32x2 q = __builtin_nontemporal_load((const u32x2*)(f + (size_t)row * D_MODEL + 4 * (lane + 64 * i))); v[i] = (f32x4){bflo(q.x), bfhi(q.x), bflo(q.y), bfhi(q.y)}; ss += v[i][0] * v[i][0] + v[i][1] * v[i][1] + v[i][2] * v[i][2] + v[i][3] * v[i][3]; }
    ss = wave_sum(ss);
    const float rs = rsqrtf(ss * (1.f / D_MODEL) + EPS);
#pragma unroll
    for (int i = 0; i < 8; ++i) {
      const f32x4 g = *(const f32x4*)(p.ln_ffn_post + 4 * (lane + 64 * i));
      __builtin_nontemporal_store(hv[i] + v[i] * rs * g, (f32x4*)(p.out + (size_t)row * D_MODEL + 4 * (lane + 64 * i)));
    }
  }
}

DI void fast_grid_barrier(unsigned* bar, unsigned k) {
  asm volatile("s_waitcnt vmcnt(0) lgkmcnt(0)" ::: "memory");
  __syncthreads();
  if (threadIdx.x == 0) {
    const unsigned g = blockIdx.x & 7u, per_group = gridDim.x >> 3;
    unsigned* sub = bar + 64 * (1 + g); unsigned* gen = bar + 64 * (9 + g); unsigned* top = bar;
    __builtin_amdgcn_fence(__ATOMIC_RELEASE, "agent");
    asm volatile("s_waitcnt vmcnt(0)" ::: "memory");
    const unsigned old = __hip_atomic_fetch_add(sub, 1u, __ATOMIC_RELAXED, __HIP_MEMORY_SCOPE_AGENT);
    if (old + 1u == k * per_group) {
      __hip_atomic_fetch_add(top, 1u, __ATOMIC_RELAXED, __HIP_MEMORY_SCOPE_AGENT);
      while (__hip_atomic_load(top, __ATOMIC_RELAXED, __HIP_MEMORY_SCOPE_AGENT) < 8u * k) __builtin_amdgcn_s_sleep(1);
      __hip_atomic_store(gen, k, __ATOMIC_RELAXED, __HIP_MEMORY_SCOPE_AGENT);
    } else {
      while (__hip_atomic_load(gen, __ATOMIC_RELAXED, __HIP_MEMORY_SCOPE_AGENT) < k) __builtin_amdgcn_s_sleep(1);
    }
    __builtin_amdgcn_fence(__ATOMIC_ACQUIRE, "agent");
    asm volatile("s_waitcnt vmcnt(0)" ::: "memory");
  }
  __syncthreads();
}
#define CAS __attribute__((address_space(4)))
DI Params load_params() {
#if !defined(__HIP_DEVICE_COMPILE__)
  return Params{};
#else
  const CAS char* base = (const CAS char*)__builtin_amdgcn_kernarg_segment_ptr();
  asm volatile("" : "+s"(base));
  return *(const CAS Params*)base;
#endif
}
#ifndef ONLY_PHASE
#define ONLY_PHASE -1
#endif
#define PH_EN(n) (ONLY_PHASE < 0 || ONLY_PHASE == (n))
__global__ void __launch_bounds__(NTHREADS) fwd_megakernel(Params pk) {
  extern __shared__ __attribute__((aligned(16))) char smem[];
  cg::grid_group grid = cg::this_grid();
#ifndef PROBE_SB
#define PROBE_SB 1
#endif
#ifndef PROBE_PHASE
#define PROBE_PHASE -1
#endif
#define PHASE(n) if (PH_EN(n) && pk.phase_begin <= (n) && (n) < pk.phase_end) for (int rep_ = 0; rep_ < ((n) == PROBE_PHASE ? 2 : 1); ++rep_)
#define SYNC(n) if ((n) > pk.phase_begin && rep_ == 0) { fast_grid_barrier((unsigned*)(pk.ws + OFF_BAR), (unsigned)((n) - pk.phase_begin)); } if (rep_ > 0) __syncthreads(); const Params p = load_params(); char* ws = p.ws; (void)ws
  if (pk.phase_begin > 1000) grid.sync();
  PHASE(0) { SYNC(0); prep_phase(p, smem); }
  PHASE(1) { SYNC(1); gemm_phase<0>(p, (const bf16_t*)(ws + OFF_A), (const bf16_t*)(ws + OFF_WINT), NTOK, PROJ_N, 2048, ws + OFF_PROJ, nullptr, smem); }
  PHASE(2) { SYNC(2);
#if DN_V1
    for (int c = blockIdx.x; c < NCHUNK; c += gridDim.x) dn_chunk(p, c, smem);
    __syncthreads();
#endif
#if DN_V1 != 1
    { const int wave = launder_tid() >> 6;
      for (int c = blockIdx.x * 8 + wave; c < NCHUNK; c += gridDim.x * 8) dn_chunk_wave(p, c, smem); }
#endif
  }
  PHASE(3) { SYNC(3); const int TIDX = launder_tid();
    for (int u = blockIdx.x; u < 64; u += gridDim.x) { dn_scan_block(p, u, smem); __syncthreads(); }
    unsigned* qctr = (unsigned*)(ws + OFF_QCTR);
    const int wave = TIDX >> 6;
    bf16_t* vl = (bf16_t*)(smem + 64) + wave * (32 * VS_LD);
    constexpr int SB_UNITS = BATCH * 8 * 128 / 8;
    for (;;) {
      __syncthreads();
      if (TIDX == 0) *(volatile unsigned*)smem = atomicAdd(qctr, 1u);
      __syncthreads();
      const unsigned item = *(volatile unsigned*)smem;
      if (item >= (unsigned)(SB_UNITS + CONV_UNITS)) break;
      if (item < (unsigned)SB_UNITS) sb_unit(p, (int)item * 8 + wave, vl);
      else { __syncthreads(); convert_unit(p, (int)item - SB_UNITS, smem); }
    }
  }
  PHASE(4) { SYNC(4); dn_final_phase(p); }
  PHASE(5) { SYNC(5); gemm_phase<1>(p, (const bf16_t*)(ws + OFF_A), (const bf16_t*)(ws + OFF_WOUTT), NTOK, 2048, 2048, ws + OFF_M, nullptr, smem); }
  PHASE(6) { SYNC(6); rows_mid_phase(p); }
  PHASE(7) { SYNC(7); gemm_phase<2>(p, (const bf16_t*)(ws + OFF_A), (const bf16_t*)(ws + OFF_WUPT), NTOK, UP_N, 2048, ws + OFF_ACT, (bf16_t*)(ws + OFF_HALO), smem); }
  PHASE(8) { SYNC(8); ffn_fix_phase(p, (const bf16_t*)(ws + OFF_HALO), (bf16_t*)(ws + OFF_ACT)); }
  PHASE(9) { SYNC(9); gemm_phase<1>(p, (const bf16_t*)(ws + OFF_ACT), (const bf16_t*)(ws + OFF_WDOWNT), NTOK, 2048, D_FF, ws + OFF_F, nullptr, smem); }
  PHASE(10) { SYNC(10);
#ifdef PROBE_SYNCS
    for (int i_ = 0; i_ < 10; ++i_) fast_grid_barrier((unsigned*)(pk.ws + OFF_BAR), (unsigned)(10 + i_));
#endif
    rows_final_phase(p); }
}

constexpr int NPHASES = 11;
#ifndef MK_SINGLE_LAUNCH
#define MK_SINGLE_LAUNCH 1
#endif

extern "C" void kernel_launch(void* const* d_in, const int* in_sizes, int n_in, void* d_out, int out_size, void* d_ws, size_t ws_size, hipStream_t stream) {
  static int grid_blocks = 0;
  if (!grid_blocks) {
    hipFuncSetAttribute((const void*)fwd_megakernel, hipFuncAttributeMaxDynamicSharedMemorySize, LDS_BYTES);
    int dev = 0, cus = 0, per_cu = 0;
    hipGetDevice(&dev);
    hipDeviceGetAttribute(&cus, hipDeviceAttributeMultiprocessorCount, dev);
    hipOccupancyMaxActiveBlocksPerMultiprocessor(&per_cu, fwd_megakernel, NTHREADS, LDS_BYTES);
    if (per_cu < 1) per_cu = 1;
    if (per_cu > 1) per_cu = 1;
    grid_blocks = cus * per_cu;
    if (grid_blocks > 256) grid_blocks = 256;
    grid_blocks &= ~7;
  }
  Params p{};
  p.x = (const float*)d_in[0]; p.w_in = (const float*)d_in[1]; p.sb_gain = (const float*)d_in[2]; p.dn_conv_w = (const float*)d_in[3];
  p.dn_a_log = (const float*)d_in[4]; p.dn_dt_bias = (const float*)d_in[5]; p.dn_gain = (const float*)d_in[6]; p.w_out = (const float*)d_in[7];
  p.ln_mix_pre = (const float*)d_in[8]; p.ln_mix_post = (const float*)d_in[9]; p.w_up = (const float*)d_in[10]; p.ffn_conv_w = (const float*)d_in[11];
  p.ffn_conv_b = (const float*)d_in[12]; p.w_down = (const float*)d_in[13]; p.ln_ffn_pre = (const float*)d_in[14]; p.ln_ffn_post = (const float*)d_in[15];
  p.out = (float*)d_out; p.ws = (char*)d_ws;
#if MK_SINGLE_LAUNCH
  p.phase_begin = 0; p.phase_end = NPHASES;
  hipMemsetAsync((char*)d_ws + OFF_BAR, 0, 17 * 256, stream);
  void* args[] = {&p};
  hipError_t e = hipLaunchCooperativeKernel((const void*)fwd_megakernel, dim3(grid_blocks), dim3(NTHREADS), args, LDS_BYTES, stream);
  if (e != hipSuccess) fprintf(stderr, "cooperative launch failed: %s (grid %d)\n", hipGetErrorString(e), grid_blocks);
#else
  for (int ph = 0; ph < NPHASES; ++ph) {
    p.phase_begin = ph; p.phase_end = ph + 1;
    hipLaunchKernelGGL(fwd_megakernel, dim3(grid_blocks), dim3(NTHREADS), LDS_BYTES, stream, p);
  }
#endif
}
```
